# Optimizing an MI355X kernel written in HIP

```python
import math
import jax, jax.numpy as jnp
from jax import lax
import numpy as np

D_MODEL = 4096
BATCH = 8
SEQ = 2048
DEPTH = 1
DEC_BATCH = 4
DEC_SEQ = 4096
PAST_LEN = 128

HEAD_DIM = 128
N_ATTN_HEADS = D_MODEL // 2 // HEAD_DIM
N_KV_HEADS = N_ATTN_HEADS // 4
ATTN_WIDTH = N_ATTN_HEADS * HEAD_DIM
KV_WIDTH = N_KV_HEADS * HEAD_DIM
WINDOW = 128
BLOCK = 128
GLA_DV = 256
N_GLA_HEADS = D_MODEL // 2 // GLA_DV
GLA_DK = GLA_DV // 2
GLA_K_WIDTH = N_GLA_HEADS * GLA_DK
GLA_V_WIDTH = N_GLA_HEADS * GLA_DV
GATE_RANK = 16
GATE_TEMP = 16.0
CHUNK = 32
MIX_WIDTH = ATTN_WIDTH + GLA_V_WIDTH
IN_WIDTH = ATTN_WIDTH + 2 * KV_WIDTH + 2 * GLA_K_WIDTH + 2 * GLA_V_WIDTH + 2 * GATE_RANK
D_FF = 4 * D_MODEL
N_BUCKETS = 32
MAX_DISTANCE = 128
EPS = 1e-6
NEG_INF = -1e30

kernel_name = "hymba_style_window_gqa_gla_encoder"


def _rms(x, g):
    xf = x.astype(jnp.float32)
    y = xf * lax.rsqrt(jnp.mean(xf * xf, axis=-1, keepdims=True) + EPS)
    return (y * g.astype(jnp.float32)).astype(x.dtype)


def _t5_bucket(rel):
    half = N_BUCKETS // 2
    max_exact = half // 2
    ret = jnp.where(rel > 0, half, 0)
    n = jnp.abs(rel)
    nf = jnp.maximum(n, 1).astype(jnp.float32)
    large = max_exact + (jnp.log(nf / max_exact) / math.log(MAX_DISTANCE / max_exact)
                         * (half - max_exact)).astype(jnp.int32)
    large = jnp.minimum(large, half - 1)
    return ret + jnp.where(n < max_exact, n, large)


def _split_proj(proj):
    sizes = [ATTN_WIDTH, KV_WIDTH, KV_WIDTH, GLA_K_WIDTH, GLA_K_WIDTH,
             GLA_V_WIDTH, GLA_V_WIDTH, GATE_RANK, GATE_RANK]
    idx = np.cumsum(sizes)[:-1].tolist()
    return jnp.split(proj, idx, axis=-1)


def _window_attention(q, k, v, sink, rel_bias):
    B, S, _ = q.shape
    nb = S // BLOCK
    G = N_ATTN_HEADS // N_KV_HEADS
    qb = q.reshape(B, nb, BLOCK, N_KV_HEADS, G, HEAD_DIM)

    def windows(t):
        t = t.reshape(B, S, N_KV_HEADS, HEAD_DIM)
        tp = jnp.pad(t, ((0, 0), (BLOCK, BLOCK), (0, 0), (0, 0)))
        tp = tp.reshape(B, nb + 2, BLOCK, N_KV_HEADS, HEAD_DIM)
        return jnp.concatenate([tp[:, :-2], tp[:, 1:-1], tp[:, 2:]], axis=2)

    kw, vw = windows(k), windows(v)
    s = jnp.einsum('bnqkgd,bnjkd->bnkgqj', qb, kw).astype(jnp.float32) * (HEAD_DIM ** -0.5)
    qi = jnp.arange(BLOCK)[:, None]
    kj = jnp.arange(3 * BLOCK)[None, :]
    rel = kj - BLOCK - qi
    bias = rel_bias[_t5_bucket(rel)].astype(jnp.float32)
    bias = bias.transpose(2, 0, 1).reshape(N_KV_HEADS, G, BLOCK, 3 * BLOCK)
    kpos = (jnp.arange(nb)[:, None] - 1) * BLOCK + jnp.arange(3 * BLOCK)[None, :]
    valid = (jnp.abs(rel) <= WINDOW)[None] & ((kpos >= 0) & (kpos < S))[:, None, :]
    s = jnp.where(valid[None, :, None, None], s + bias, NEG_INF)
    sink_l = jnp.broadcast_to(sink.astype(jnp.float32).reshape(N_KV_HEADS, G, 1, 1), s.shape[:-1] + (1,))
    p = jax.nn.softmax(jnp.concatenate([s, sink_l], axis=-1), axis=-1)[..., :-1]
    o = jnp.einsum('bnkgqj,bnjkd->bnqkgd', p.astype(v.dtype), vw)
    return o.reshape(B, S, ATTN_WIDTH)


def _gla_direction(q, k, v, logg):
    B, H, S, dk = q.shape
    dv = v.shape[-1]
    nc = S // CHUNK
    qc = q.reshape(B, H, nc, CHUNK, dk)
    kc = k.reshape(B, H, nc, CHUNK, dk)
    vc = v.reshape(B, H, nc, CHUNK, dv)
    gc = logg.reshape(B, H, nc, CHUNK, dk)
    b = jnp.cumsum(gc, axis=3)
    b_last = b[:, :, :, -1:, :]
    q_t = qc * jnp.exp(b)
    k_t = kc * jnp.exp(-b)
    mask = jnp.tril(jnp.ones((CHUNK, CHUNK), dtype=bool))
    A = jnp.where(mask, jnp.einsum('bhnck,bhnsk->bhncs', q_t, k_t), 0.0)
    o_intra = jnp.einsum('bhncs,bhnsv->bhncv', A, vc)
    k_dec = kc * jnp.exp(b_last - b)
    decay = jnp.exp(b_last[:, :, :, 0, :])

    def step(state, inp):
        q_n, k_n, v_n, d_n = inp
        o_n = jnp.einsum('bhck,bhkv->bhcv', q_n, state)
        state = state * d_n[..., None] + jnp.einsum('bhck,bhcv->bhkv', k_n, v_n)
        return state, o_n

    xs = (jnp.moveaxis(q_t, 2, 0), jnp.moveaxis(k_dec, 2, 0),
          jnp.moveaxis(vc, 2, 0), jnp.moveaxis(decay, 2, 0))
    _, o_inter = lax.scan(step, jnp.zeros((B, H, dk, dv), jnp.float32), xs)
    return (o_intra + jnp.moveaxis(o_inter, 0, 2)).reshape(B, H, S, dv)


def _gla_mixer(qg, kg, vg, rg, af, ab, wa_f, ba_f, wa_b, ba_b, norm_g):
    B, S, _ = qg.shape

    def heads(t, d):
        return t.reshape(B, S, N_GLA_HEADS, d).transpose(0, 2, 1, 3).astype(jnp.float32)

    q = heads(qg, GLA_DK) * (GLA_DK ** -0.5)
    k = heads(kg, GLA_DK)
    v = heads(vg, GLA_DV)
    lg_f = heads(jax.nn.log_sigmoid((af @ wa_f + ba_f).astype(jnp.float32)) / GATE_TEMP, GLA_DK)
    lg_b = heads(jax.nn.log_sigmoid((ab @ wa_b + ba_b).astype(jnp.float32)) / GATE_TEMP, GLA_DK)
    o_f = _gla_direction(q, k, v, lg_f)
    flip = lambda t: jnp.flip(t, axis=2)
    o_b = flip(_gla_direction(flip(q), flip(k), flip(v), flip(lg_b)))
    o = o_f + o_b
    o = o * lax.rsqrt(jnp.mean(o * o, axis=-1, keepdims=True) + EPS) * norm_g.astype(jnp.float32)
    o = o.transpose(0, 2, 1, 3).reshape(B, S, GLA_V_WIDTH).astype(rg.dtype)
    return o * jax.nn.silu(rg)


def _layer(x, c, w_ada, b_ada, norm1_g, w_in, gla_wa_fwd, gla_ba_fwd, gla_wa_bwd, gla_ba_bwd,
           gla_norm_g, attn_sink, rel_bias, w_out, norm2_g, w_mlp_in, w_mlp_out):
    mod = jax.nn.silu(c) @ w_ada + b_ada
    sh1, sc1, g1, sh2, sc2, g2 = jnp.split(mod[:, None, :], 6, axis=-1)
    h = _rms(x, norm1_g) * (1.0 + sc1) + sh1
    qa, ka, va, qg, kg, vg, rg, af, ab = _split_proj(h @ w_in)
    attn = _window_attention(qa, ka, va, attn_sink, rel_bias)
    gla = _gla_mixer(qg, kg, vg, rg, af, ab, gla_wa_fwd, gla_ba_fwd, gla_wa_bwd, gla_ba_bwd, gla_norm_g)
    x = x + g1 * (jnp.concatenate([attn, gla], axis=-1) @ w_out)
    h = _rms(x, norm2_g) * (1.0 + sc2) + sh2
    x = x + g2 * (jnp.square(jax.nn.relu(h @ w_mlp_in)) @ w_mlp_out)
    return x


def _trunk(x, c, w_ada, b_ada, norm1_g, w_in, gla_wa_fwd, gla_ba_fwd, gla_wa_bwd, gla_ba_bwd,
           gla_norm_g, attn_sink, rel_bias, w_out, norm2_g, w_mlp_in, w_mlp_out, final_g):
    for l in range(DEPTH):
        x = _layer(x, c, w_ada[l], b_ada[l], norm1_g[l], w_in[l], gla_wa_fwd[l], gla_ba_fwd[l],
                   gla_wa_bwd[l], gla_ba_bwd[l], gla_norm_g[l], attn_sink[l], rel_bias,
                   w_out[l], norm2_g[l], w_mlp_in[l], w_mlp_out[l])
    return _rms(x, final_g)


def setup_inputs(seed: int = 0) -> dict:
    key = jax.random.key(seed)
    ks = jax.random.split(key, 24)
    f32 = jnp.float32
    nrm = lambda k, shape, s: jax.random.normal(k, shape, f32) * s
    return {
        "x_prompt": nrm(ks[0], (BATCH, SEQ, D_MODEL), 1.0),
        "x_sample": nrm(ks[1], (DEC_BATCH, DEC_SEQ, D_MODEL), 1.0),
        "c_prompt": nrm(ks[2], (BATCH, D_MODEL), 1.0),
        "c_sample": nrm(ks[3], (DEC_BATCH, D_MODEL), 1.0),
        "w_ada": nrm(ks[4], (DEPTH, D_MODEL, 6 * D_MODEL), D_MODEL ** -0.5),
        "b_ada": nrm(ks[5], (DEPTH, 6 * D_MODEL), 0.01),
        "norm1_g": 1.0 + nrm(ks[6], (DEPTH, D_MODEL), 0.02),
        "w_in": nrm(ks[7], (DEPTH, D_MODEL, IN_WIDTH), D_MODEL ** -0.5),
        "gla_wa_fwd": nrm(ks[8], (DEPTH, GATE_RANK, GLA_K_WIDTH), GATE_RANK ** -0.5),
        "gla_ba_fwd": nrm(ks[9], (DEPTH, GLA_K_WIDTH), 0.1),
        "gla_wa_bwd": nrm(ks[10], (DEPTH, GATE_RANK, GLA_K_WIDTH), GATE_RANK ** -0.5),
        "gla_ba_bwd": nrm(ks[11], (DEPTH, GLA_K_WIDTH), 0.1),
        "gla_norm_g": 1.0 + nrm(ks[12], (DEPTH, GLA_DV), 0.02),
        "attn_sink": nrm(ks[13], (DEPTH, N_ATTN_HEADS), 1.0),
        "rel_bias": nrm(ks[14], (N_BUCKETS, N_ATTN_HEADS), 0.5),
        "w_out": nrm(ks[15], (DEPTH, MIX_WIDTH, D_MODEL), MIX_WIDTH ** -0.5),
        "norm2_g": 1.0 + nrm(ks[16], (DEPTH, D_MODEL), 0.02),
        "w_mlp_in": nrm(ks[17], (DEPTH, D_MODEL, D_FF), D_MODEL ** -0.5),
        "w_mlp_out": nrm(ks[18], (DEPTH, D_FF, D_MODEL), D_FF ** -0.5),
        "final_g": 1.0 + nrm(ks[19], (D_MODEL,), 0.02),
    }


def reference(x_prompt, x_sample, c_prompt, c_sample, w_ada, b_ada, norm1_g, w_in,
              gla_wa_fwd, gla_ba_fwd, gla_wa_bwd, gla_ba_bwd, gla_norm_g, attn_sink, rel_bias,
              w_out, norm2_g, w_mlp_in, w_mlp_out, final_g):
    y_prompt = _trunk(x_prompt, c_prompt, w_ada, b_ada, norm1_g, w_in, gla_wa_fwd, gla_ba_fwd,
                      gla_wa_bwd, gla_ba_bwd, gla_norm_g, attn_sink, rel_bias, w_out, norm2_g,
                      w_mlp_in, w_mlp_out, final_g)
    y_sample = _trunk(x_sample, c_sample, w_ada, b_ada, norm1_g, w_in, gla_wa_fwd, gla_ba_fwd,
                      gla_wa_bwd, gla_ba_bwd, gla_norm_g, attn_sink, rel_bias, w_out, norm2_g,
                      w_mlp_in, w_mlp_out, final_g)
    return (y_prompt, y_sample)
```

```cpp
#include <hip/hip_runtime.h>
#include <cstdio>
#include <cstdint>
namespace pg8 {
#define PG8_LAS __attribute__((address_space(3)))
typedef unsigned short bf16_t;
typedef short bf16x8 __attribute__((ext_vector_type(8)));
typedef float f32x4 __attribute__((ext_vector_type(4)));
typedef unsigned u32x4 __attribute__((ext_vector_type(4)));
constexpr int BM = 256, BK = 64, HALF = 128, HTB = HALF * BK * 2  , STAGE_BYTES = 8 * HTB, NXCD = 8, WGM = 8;

__host__ __device__ __forceinline__ int lds_byte(int r, int c) { const int st = (r >> 4) * 2 + (c >> 5), rr = r & 15, cc = c & 31, ob = rr * 64 + cc * 2; return st * 1024 + (ob ^ (((ob >> 9) & 1) << 5)); }
__host__ __device__ __forceinline__ void stage_rc(int b, int& R, int& C) { const int st = b / 1024, sb = b % 1024, swz = sb ^ (((sb >> 9) & 1) << 5); R = (st >> 1) * 16 + swz / 64; C = (st & 1) * 32 + (swz % 64) / 2; }
__host__ __device__ __forceinline__ int perm32(int rho) { const int n = rho >> 4, i = rho & 15; return 8 * (i >> 2) + 4 * n + (i & 3); }

struct Unit { int pm, pn; };
struct Gemm { const bf16_t* A; const bf16_t* Bt; int M, N, K; };

struct StaticOrder {
    int nM, nN, nwg, G, c;
    __host__ __device__ void init(int M, int N, int G_, int c_) { nM = M / BM; nN = N / BM; nwg = nM * nN; G = G_; c = c_; }
    __host__ __device__ bool next(int i, Unit& u) const {
        const long L = (long)i * G + c; if (L >= nwg) return false;
        int wgid = (int)L; { const int q = nwg / NXCD, r = nwg % NXCD, xcd = wgid % NXCD, off = wgid / NXCD; wgid = (xcd < r ? xcd * (q + 1) : r * (q + 1) + (xcd - r) * q) + off; }
        const int nig = WGM * nN, gid = wgid / nig, fm = gid * WGM, gsz = (nM - fm) < WGM ? (nM - fm) : WGM;
        u.pm = fm + ((wgid % nig) % gsz); u.pn = (wgid % nig) / gsz; return true;
    }
    __device__ __forceinline__ void a_ready(const Unit&) const {}
    __device__ __forceinline__ void done(const Unit&) const {}
};


typedef float f32x2 __attribute__((ext_vector_type(2)));
typedef __bf16 bf16v2 __attribute__((ext_vector_type(2)));
__device__ __forceinline__ unsigned cvt_pk_bf16(float lo, float hi) { const f32x2 v = {lo, hi}; return __builtin_bit_cast(unsigned, __builtin_convertvector(v, bf16v2)); }

template <int ACT  > struct EpiBf16 {
    static constexpr bool PERM = true, AFTER_DRAIN = false;
    bf16_t* O; int ldc;
    __device__ __forceinline__ void operator()(const f32x4 (&acc)[2][2][4][2], const Unit& u, int wr, int wc, int fr, int fq) const {
        const int row0 = u.pm * BM + wr * 64 + fr, col0 = u.pn * BM + wc * 32 + 8 * fq;
#pragma unroll
        for (int ai = 0; ai < 2; ++ai)
#pragma unroll
            for (int m = 0; m < 4; ++m) { bf16_t* rowp = O + (size_t)(row0 + ai * HALF + m * 16) * ldc + col0;
#pragma unroll
                for (int bj = 0; bj < 2; ++bj) { f32x4 v0 = acc[ai][bj][m][0], v1 = acc[ai][bj][m][1];
                    if (ACT == 1) {
#pragma unroll
                        for (int j = 0; j < 4; ++j) { const float a = fmaxf(v0[j], 0.f), b = fmaxf(v1[j], 0.f); v0[j] = a * a; v1[j] = b * b; } }
                    u32x4 w; w.x = cvt_pk_bf16(v0[0], v0[1]); w.y = cvt_pk_bf16(v0[2], v0[3]); w.z = cvt_pk_bf16(v1[0], v1[1]); w.w = cvt_pk_bf16(v1[2], v1[3]);
                    *(u32x4*)(rowp + bj * HALF) = w; } }
    }
};
struct EpiResid {
    static constexpr bool PERM = false, AFTER_DRAIN = false;
    const float* xp; const float* xs; float* out; const float* mod; int goff; int row_base;
    __device__ __forceinline__ void operator()(const f32x4 (&acc)[2][2][4][2], const Unit& u, int wr, int wc, int fr, int fq) const {
        const int R0 = row_base + u.pm * BM;
        const int b = R0 < 16384 ? (R0 >> 11) : 8 + ((R0 - 16384) >> 12);
        const float* src = R0 < 16384 ? xp + (size_t)R0 * 4096 : xs + (size_t)(R0 - 16384) * 4096;
        float* dst = out + (size_t)R0 * 4096;
        const float* gate = mod + b * 24576 + goff;
        const int rl = wr * 64 + fr, col0 = u.pn * BM + wc * 32 + 4 * fq;
        f32x4 gv[2][2];
#pragma unroll
        for (int bj = 0; bj < 2; ++bj)
#pragma unroll
            for (int n = 0; n < 2; ++n) gv[bj][n] = *(const f32x4*)(gate + col0 + bj * HALF + n * 16);
#pragma unroll
        for (int ai = 0; ai < 2; ++ai)
#pragma unroll
            for (int m = 0; m < 4; ++m) { const size_t off = (size_t)(rl + ai * HALF + m * 16) * 4096 + col0;
#pragma unroll
                for (int bj = 0; bj < 2; ++bj)
#pragma unroll
                    for (int n = 0; n < 2; ++n) { const f32x4 s = *(const f32x4*)(src + off + bj * HALF + n * 16);
                        *(f32x4*)(dst + off + bj * HALF + n * 16) = s + gv[bj][n] * acc[ai][bj][m][n]; } }
    }
};

template <class Epi, class Sched, bool ALIGN_EPI = false, bool SP2 = false>
__device__ __forceinline__ void gemm_phase(PG8_LAS unsigned char* lds, const Gemm g, const Sched& S, const Epi& E) {
    const int tid = threadIdx.x, wid = __builtin_amdgcn_readfirstlane(tid >> 6), lane = tid & 63, wr = wid >> 2, wc = wid & 3, fr = lane & 15, fq = lane >> 4;
    const int K = g.K, nt = K / BK;
    unsigned voffA[2], voffB[2];
#pragma unroll
    for (int i = 0; i < 2; ++i) { int R, C; stage_rc(tid * 16 + i * 8192, R, C); const int Rb = Epi::PERM ? ((R & ~31) + perm32(R & 31)) : R;
        voffA[i] = (unsigned)(R * K + C) * 2u; voffB[i] = (unsigned)(Rb * K + C) * 2u; }
    const size_t kstep = (size_t)(BK * 2);
    const size_t hstep = (size_t)HALF * K * 2;
    const size_t tstep = 2 * hstep;
    const unsigned ldsw = (unsigned)wid * 1024u;
    const int aoff = lds_byte(wr * 64 + fr, fq * 8), boff = lds_byte(wc * 32 + fr, fq * 8);
#define PG8_SA(b, h) (((b) * 2 + (h)) * HTB)
#define PG8_SB(b, h) ((4 + (b) * 2 + (h)) * HTB)
#define PG8_STAGE(bufoff, gbase, voff) do { _Pragma("unroll") for (int _i = 0; _i < 2; ++_i) \
        __builtin_amdgcn_global_load_lds((const unsigned*)((const char*)(gbase) + (voff)[_i]), (PG8_LAS unsigned*)(lds + (bufoff) + ldsw + _i * 8192), 16, 0, 0); } while (0)
#define PG8_LDA(dst, b, h) do { _Pragma("unroll") for (int m = 0; m < 4; ++m) _Pragma("unroll") for (int k = 0; k < 2; ++k) dst[m][k] = *(const PG8_LAS bf16x8*)(lds + PG8_SA(b, h) + aoff + m * 2048 + k * 1024); } while (0)
#define PG8_LDB(dst, b, h) do { _Pragma("unroll") for (int n = 0; n < 2; ++n) _Pragma("unroll") for (int k = 0; k < 2; ++k) dst[n][k] = *(const PG8_LAS bf16x8*)(lds + PG8_SB(b, h) + boff + n * 2048 + k * 1024); } while (0)
#define PG8_MMA(ai, bj, At, Bt) do { __builtin_amdgcn_s_setprio(1); _Pragma("unroll") for (int m = 0; m < 4; ++m) _Pragma("unroll") for (int n = 0; n < 2; ++n) _Pragma("unroll") for (int k = 0; k < 2; ++k) \
        acc[ai][bj][m][n] = __builtin_amdgcn_mfma_f32_16x16x32_bf16(Bt[n][k], At[m][k], acc[ai][bj][m][n], 0, 0, 0); __builtin_amdgcn_s_setprio(0); } while (0)
#define PG8_WAIT_V(n) asm volatile("s_waitcnt vmcnt(" #n ")" ::: "memory")
#define PG8_WAIT_L(n) asm volatile("s_waitcnt lgkmcnt(" #n ")" ::: "memory")
#define PG8_BAR __builtin_amdgcn_s_barrier()
#define PG8_SCHED __builtin_amdgcn_sched_barrier(0)
    Unit cur, nxt; int ui = 0;
    if (!S.next(0, cur)) return;
    f32x4 acc[2][2][4][2];
#pragma unroll
    for (int a = 0; a < 2; ++a)
#pragma unroll
        for (int b = 0; b < 2; ++b)
#pragma unroll
            for (int m = 0; m < 4; ++m)
#pragma unroll
                for (int n = 0; n < 2; ++n) acc[a][b][m][n] = (f32x4){0.f, 0.f, 0.f, 0.f};
    bf16x8 At[4][2], B0[2][2], B1[2][2];
    const char* cA = (const char*)g.A + (size_t)cur.pm * tstep; const char* cB = (const char*)g.Bt + (size_t)cur.pn * tstep;
    S.a_ready(cur);
    if constexpr (SP2) {
        PG8_STAGE(PG8_SB(0, 0), cB, voffB); PG8_STAGE(PG8_SB(0, 1), cB + hstep, voffB); PG8_STAGE(PG8_SA(0, 0), cA, voffA); PG8_STAGE(PG8_SA(0, 1), cA + hstep, voffA);
        if (wr == 1) PG8_BAR;
        PG8_WAIT_V(2); PG8_BAR;
        PG8_STAGE(PG8_SB(1, 0), cB + kstep, voffB); PG8_STAGE(PG8_SA(1, 0), cA + kstep, voffA); PG8_STAGE(PG8_SB(1, 1), cB + hstep + kstep, voffB);
        PG8_WAIT_V(6); PG8_BAR;
    } else {
        PG8_STAGE(PG8_SB(0, 0), cB, voffB); PG8_STAGE(PG8_SA(0, 0), cA, voffA); PG8_STAGE(PG8_SB(0, 1), cB + hstep, voffB); PG8_STAGE(PG8_SA(0, 1), cA + hstep, voffA);
        if (wr == 1) PG8_BAR;
        PG8_WAIT_V(4); PG8_BAR;
        PG8_STAGE(PG8_SB(1, 0), cB + kstep, voffB); PG8_STAGE(PG8_SA(1, 0), cA + kstep, voffA); PG8_STAGE(PG8_SB(1, 1), cB + hstep + kstep, voffB);
        PG8_WAIT_V(6); PG8_BAR;
    }
    for (;;) {
        const bool has_next = S.next(ui + 1, nxt);
        const char* nA = has_next ? (const char*)g.A + (size_t)nxt.pm * tstep : cA; const char* nB = has_next ? (const char*)g.Bt + (size_t)nxt.pn * tstep : cB;
        for (int t = 0; t < nt; t += 2) {
            const bool last = (t == nt - 2);
            const char* a1 = cA + (size_t)(t + 1) * kstep;
            const char* a2 = last ? nA : cA + (size_t)(t + 2) * kstep; const char* b2 = last ? nB : cB + (size_t)(t + 2) * kstep;
            const char* a3 = a2 + kstep; const char* b3 = b2 + kstep;
            if (last && has_next) S.a_ready(nxt);
            if constexpr (SP2) {
            PG8_LDB(B0, 0, 0); PG8_LDB(B1, 0, 1); PG8_SCHED; PG8_LDA(At, 0, 0); PG8_STAGE(PG8_SA(1, 1), a1 + hstep, voffA);
            PG8_WAIT_V(8); PG8_WAIT_L(0); PG8_BAR; PG8_MMA(0, 0, At, B0); PG8_MMA(0, 1, At, B1); PG8_BAR; PG8_SCHED;
            PG8_LDA(At, 0, 1); PG8_STAGE(PG8_SB(0, 0), b2, voffB); PG8_STAGE(PG8_SB(0, 1), b2 + hstep, voffB); PG8_STAGE(PG8_SA(0, 0), a2, voffA);
            PG8_WAIT_V(8); PG8_WAIT_L(0); PG8_BAR; PG8_MMA(1, 0, At, B0); PG8_MMA(1, 1, At, B1); PG8_BAR; PG8_SCHED;
            PG8_LDB(B0, 1, 0); PG8_LDB(B1, 1, 1); PG8_SCHED; PG8_LDA(At, 1, 0); PG8_STAGE(PG8_SA(0, 1), a2 + hstep, voffA);
            PG8_WAIT_V(8); PG8_WAIT_L(0); PG8_BAR; PG8_MMA(0, 0, At, B0); PG8_MMA(0, 1, At, B1); PG8_BAR; PG8_SCHED;
            PG8_LDA(At, 1, 1); PG8_STAGE(PG8_SB(1, 0), b3, voffB); PG8_STAGE(PG8_SB(1, 1), b3 + hstep, voffB); PG8_STAGE(PG8_SA(1, 0), a3, voffA);
            PG8_WAIT_V(8); PG8_WAIT_L(0); PG8_BAR; PG8_MMA(1, 0, At, B0); PG8_MMA(1, 1, At, B1); PG8_BAR; PG8_SCHED;
            } else {
            PG8_LDB(B0, 0, 0); PG8_SCHED; PG8_LDA(At, 0, 0); PG8_STAGE(PG8_SA(1, 1), a1 + hstep, voffA);
            PG8_WAIT_L(8); PG8_BAR; PG8_WAIT_L(0); PG8_MMA(0, 0, At, B0); PG8_BAR; PG8_SCHED;
            PG8_LDB(B1, 0, 1); PG8_STAGE(PG8_SB(0, 0), b2, voffB);
            PG8_BAR; PG8_WAIT_L(0); PG8_MMA(0, 1, At, B1); PG8_BAR;
            PG8_LDA(At, 0, 1); PG8_STAGE(PG8_SA(0, 0), a2, voffA);
            PG8_BAR; PG8_WAIT_L(0); PG8_MMA(1, 0, At, B0); PG8_BAR; PG8_SCHED;
            PG8_STAGE(PG8_SB(0, 1), b2 + hstep, voffB);
            PG8_WAIT_V(6); PG8_BAR; PG8_MMA(1, 1, At, B1); PG8_BAR;
            PG8_LDB(B0, 1, 0); PG8_SCHED; PG8_LDA(At, 1, 0); PG8_STAGE(PG8_SA(0, 1), a2 + hstep, voffA);
            PG8_WAIT_L(8); PG8_BAR; PG8_WAIT_L(0); PG8_MMA(0, 0, At, B0); PG8_BAR; PG8_SCHED;
            PG8_LDB(B1, 1, 1); PG8_STAGE(PG8_SB(1, 0), b3, voffB);
            PG8_BAR; PG8_WAIT_L(0); PG8_MMA(0, 1, At, B1); PG8_BAR;
            PG8_LDA(At, 1, 1); PG8_STAGE(PG8_SA(1, 0), a3, voffA);
            PG8_BAR; PG8_WAIT_L(0); PG8_MMA(1, 0, At, B0); PG8_BAR; PG8_SCHED;
            PG8_STAGE(PG8_SB(1, 1), b3 + hstep, voffB);
            PG8_WAIT_V(6); PG8_BAR; PG8_MMA(1, 1, At, B1); PG8_BAR;
            }
        }
        if constexpr (ALIGN_EPI) { if (wr == 0) PG8_BAR; }
        if constexpr (!Epi::AFTER_DRAIN) { E(acc, cur, wr, wc, fr, fq); S.done(cur); }
        if (!has_next) break;
#pragma unroll
        for (int a = 0; a < 2; ++a)
#pragma unroll
            for (int b = 0; b < 2; ++b)
#pragma unroll
                for (int m = 0; m < 4; ++m)
#pragma unroll
                    for (int n = 0; n < 2; ++n) acc[a][b][m][n] = (f32x4){0.f, 0.f, 0.f, 0.f};
        cur = nxt; cA = nA; cB = nB; ++ui;
        if constexpr (ALIGN_EPI) { if (wr == 1) PG8_BAR; }
    }
    PG8_WAIT_V(0);
    if constexpr (!ALIGN_EPI) { if (wr == 0) PG8_BAR; }
    PG8_BAR;
    if constexpr (Epi::AFTER_DRAIN) { E.fused(acc, cur, wr, wc, fr, fq, lds, wid, lane); S.done(cur); }
#undef PG8_SA
#undef PG8_SB
#undef PG8_STAGE
#undef PG8_LDA
#undef PG8_LDB
#undef PG8_MMA
#undef PG8_WAIT_V
#undef PG8_WAIT_L
#undef PG8_BAR
#undef PG8_SCHED
}
}
#ifndef PG8_SP2
#define PG8_SP2 true
#endif
#ifndef PG8_ALIGN
#define PG8_ALIGN true
#endif
#ifndef MK_ONE_LAUNCH
#define MK_ONE_LAUNCH 1
#endif

constexpr int NWAVES = 8;
constexpr int T = 32768, D = 4096, TP = 16384, DFF = 16384, NIN = 9248, LDP = 9472, NB = 12, MODW = 6 * D;
constexpr int C_QA = 0, C_KA = 2048, C_VA = 2560, C_QG = 3072, C_KG = 4096, C_VG = 5120, C_RG = 7168, C_AF = 9216, C_AB = 9232;
constexpr int MLP_CH = 4, MLP_ROWS = T / MLP_CH;
constexpr int OFF_SH1 = 0, OFF_SC1 = D, OFF_G1 = 2 * D, OFF_SH2 = 3 * D, OFF_SC2 = 4 * D, OFF_G2 = 5 * D;
constexpr int N_PHASES = 16;

constexpr size_t MiB = 1u << 20;
constexpr size_t WS_CTL = 0, CTL_ZERO_BYTES = 1 * MiB;
constexpr size_t WS_MOD = 1 * MiB;
constexpr size_t WS_WIN = 4 * MiB;
constexpr size_t WS_WOUT = 78 * MiB;
constexpr size_t WS_H = 110 * MiB;
constexpr size_t WS_PROJ = 366 * MiB;
constexpr size_t WS_MIX = 958 * MiB;
constexpr size_t WS_OF = 1214 * MiB, WS_OB = 1342 * MiB;
constexpr size_t WS_END = 1470 * MiB;
constexpr size_t WS_WMI = 366 * MiB, WS_WMO = 494 * MiB;
constexpr size_t WS_HID0 = 622 * MiB, WS_HID1 = 878 * MiB;
static_assert(WS_HID1 + (size_t)MLP_ROWS * DFF * 2 <= WS_END && WS_WIN + (size_t)LDP * D * 2 <= WS_WOUT && WS_PROJ + (size_t)T * LDP * 2 <= WS_MIX, "ws map");
constexpr int CW_TMO = 0, CW_BAR = 4096, CW_QUEUE = 16384;

constexpr int RING_OFF = 0, RING_BYTES = 131072;
constexpr int LDSCTL_OFF = RING_BYTES, MISC_OFF = LDSCTL_OFF + 320;
constexpr int LDS_BYTES = 147456;

#define GAS __attribute__((address_space(1)))
#define LAS __attribute__((address_space(3)))
#define DI __device__ __forceinline__
typedef unsigned short bf16;
typedef unsigned v4u __attribute__((ext_vector_type(4)));
typedef unsigned v2u __attribute__((ext_vector_type(2)));
typedef float f32x4 __attribute__((ext_vector_type(4)));
typedef float f32x2 __attribute__((ext_vector_type(2)));
typedef float f32x16 __attribute__((ext_vector_type(16)));
typedef short bf16x8 __attribute__((ext_vector_type(8)));
typedef short s16x4 __attribute__((ext_vector_type(4)));
typedef GAS unsigned gu32;
#define RLX_AGENT __ATOMIC_RELAXED, __HIP_MEMORY_SCOPE_AGENT
#define LDS_WAIT() asm volatile("s_waitcnt lgkmcnt(0)" ::: "memory")
#define MFMA32(a, b, c) __builtin_amdgcn_mfma_f32_32x32x16_bf16((a), (b), (c), 0, 0, 0)
DI unsigned pk2(float lo, float hi) { return pg8::cvt_pk_bf16(lo, hi); }
DI float bf_lo(unsigned u) { return __builtin_bit_cast(float, u << 16); }
DI float bf_hi(unsigned u) { return __builtin_bit_cast(float, u & 0xffff0000u); }

#define XB_TMO      128
#define XB_XCNT(j)  (256  + 64 * (j))
#define XB_XSUB(j)  (1280 + 64 * (j))
#define XB_XGEN(j)  (2304 + 64 * (j))
#define XB_TOP      3328
#define XB_TOPGEN   3392
#define XCD_BAR_WORDS 3456
#define XB_SPIN_CAP (1u << 20)

DI unsigned xb_ld(unsigned* p)              { return __hip_atomic_load(p, __ATOMIC_RELAXED, __HIP_MEMORY_SCOPE_AGENT); }
DI unsigned xb_add(unsigned* p, unsigned v) { return __hip_atomic_fetch_add(p, v, __ATOMIC_RELAXED, __HIP_MEMORY_SCOPE_AGENT); }
DI unsigned xb_xcc_id() { return (unsigned)__builtin_amdgcn_s_getreg((3 << 11) | 20) & 0xFu; }
#define XB_SPIN(cond, bar) do { unsigned _sp = 0; while (cond) { __builtin_amdgcn_s_sleep(1); \
    if ((++_sp & 255u) == 0u) { if (xb_ld(&(bar)[XB_TMO])) break; if (_sp > XB_SPIN_CAP) { atomicAdd(&(bar)[XB_TMO], 1u); break; } } } } while (0)

struct XcdBarrier { unsigned* bar; unsigned x; volatile LAS unsigned* st; };
DI XcdBarrier xcd_barrier_post(unsigned* bar, volatile LAS unsigned* st) {
    XcdBarrier b; b.bar = bar; b.x = xb_xcc_id(); b.st = st;
    if (threadIdx.x == 0) (void)xb_add(&bar[XB_XCNT(b.x)], 1u);
    return b;
}
DI void xcd_barrier_complete(unsigned* bar, unsigned x, unsigned& nloc, unsigned& nx) {
    const unsigned G = gridDim.x * gridDim.y * gridDim.z;
    unsigned sum, cnt, mine, sp = 0u;
    for (;;) {
        sum = 0u; cnt = 0u; mine = 0u;
#pragma unroll
        for (unsigned j = 0; j < 16; ++j) { const unsigned c = xb_ld(&bar[XB_XCNT(j)]); sum += c; cnt += (c > 0u) ? 1u : 0u; mine = (j == x) ? c : mine; }
        if (sum == G) break;
        __builtin_amdgcn_s_sleep(1);
        if ((++sp & 255u) == 0u) { if (xb_ld(&bar[XB_TMO])) break; if (sp > XB_SPIN_CAP) { atomicAdd(&bar[XB_TMO], 1u); break; } }
    }
    nloc = mine > 0u ? mine : 1u; nx = cnt > 0u ? cnt : 1u;
}
DI void xcd_barrier(const XcdBarrier& b) {
    asm volatile("s_waitcnt vmcnt(0)" ::: "memory");
    __syncthreads();
    if (threadIdx.x == 0) {
        unsigned* bar = b.bar;
        __builtin_amdgcn_s_waitcnt(0);
        unsigned nloc = b.st[0], nx = b.st[1];
        if (nloc == 0u) { xcd_barrier_complete(bar, b.x, nloc, nx); b.st[0] = nloc; b.st[1] = nx; }
        const unsigned old = xb_add(&bar[XB_XSUB(b.x)], 1u);
        const unsigned gen = old / nloc;
        if (old + 1u == (gen + 1u) * nloc) {
            __builtin_amdgcn_fence(__ATOMIC_RELEASE, "agent");
            asm volatile("s_waitcnt vmcnt(0)" ::: "memory");
            const unsigned og = xb_add(&bar[XB_TOP], 1u);
            const unsigned tg = og / nx;
            if (og + 1u == (tg + 1u) * nx) xb_add(&bar[XB_TOPGEN], 1u);
            else XB_SPIN(xb_ld(&bar[XB_TOPGEN]) == tg, bar);
            __builtin_amdgcn_fence(__ATOMIC_ACQUIRE, "agent");
            xb_add(&bar[XB_XGEN(b.x)], 1u);
            asm volatile("s_waitcnt vmcnt(0)" ::: "memory");
        } else {
            XB_SPIN(xb_ld(&bar[XB_XGEN(b.x)]) == gen, bar);
            __builtin_amdgcn_fence(__ATOMIC_ACQUIRE, "agent");
            asm volatile("s_waitcnt vmcnt(0)" ::: "memory");
        }
    }
    __syncthreads();
}

struct Frame {
    LAS unsigned char* lds;
    volatile LAS unsigned* MISC;
    gu32* ctl;
    int tid, lane, wave;
    int vcu, G;
    const float *xp, *xs, *cp, *cs, *w_ada, *b_ada, *norm1_g, *w_in, *wa_f, *ba_f, *wa_b, *ba_b, *gla_norm_g, *sink, *rel_bias, *w_out, *norm2_g, *w_mi, *w_mo, *final_g;
    float* out; float* mod;
    bf16 *Win_t, *Wout_t, *Wmi_t, *Wmo_t, *H, *PROJ, *MIX, *OF, *OB, *HID0, *HID1;
};
DI int seq_of_row(int r) { return r < TP ? (r >> 11) : 8 + ((r - TP) >> 12); }
DI int seq_base(int s) { return s < 8 ? s * 2048 : TP + (s - 8) * 4096; }
DI int seq_len(int s) { return s < 8 ? 2048 : 4096; }
DI float wave_sum(float v) {
#pragma unroll
    for (int o = 1; o < 64; o <<= 1) v += __shfl_xor(v, o);
    return v;
}

DI void p0_mod(Frame& F) {
    LAS float* sb = (LAS float*)(F.lds + F.wave * 3072);
    LAS float* red = (LAS float*)(F.lds + 32768);
    for (int slab = F.vcu; slab < MODW / 96; slab += F.G) {
        const int col0 = slab * 96 + 2 * F.lane;
        f32x2 acc[NB];
#pragma unroll
        for (int j = 0; j < NB; ++j) acc[j] = (f32x2){0.f, 0.f};
        for (int kc = 0; kc < 8; ++kc) {
            const int k0 = F.wave * 512 + kc * 64;
#pragma unroll
            for (int j = 0; j < NB; ++j) { const float c = (j < 8) ? F.cp[j * D + k0 + F.lane] : F.cs[(j - 8) * D + k0 + F.lane];
                sb[F.lane * NB + j] = c / (1.f + __expf(-c)); }
            LDS_WAIT();
            if (F.lane < 48) {
#pragma unroll 16
                for (int kk = 0; kk < 64; ++kk) {
                    const f32x2 w = *(const f32x2*)(F.w_ada + (size_t)(k0 + kk) * MODW + col0);
                    const f32x4 s0 = *(const LAS f32x4*)(sb + kk * NB), s1 = *(const LAS f32x4*)(sb + kk * NB + 4), s2 = *(const LAS f32x4*)(sb + kk * NB + 8);
                    acc[0] += s0[0] * w; acc[1] += s0[1] * w; acc[2] += s0[2] * w; acc[3] += s0[3] * w;
                    acc[4] += s1[0] * w; acc[5] += s1[1] * w; acc[6] += s1[2] * w; acc[7] += s1[3] * w;
                    acc[8] += s2[0] * w; acc[9] += s2[1] * w; acc[10] += s2[2] * w; acc[11] += s2[3] * w;
                }
            }
            LDS_WAIT();
        }
        if (F.lane < 48) {
#pragma unroll
            for (int j = 0; j < NB; ++j) *(LAS f32x2*)(red + (F.wave * NB + j) * 96 + 2 * F.lane) = acc[j];
        }
        __syncthreads();
        for (int o = F.tid; o < NB * 96; o += NWAVES * 64) { const int j = o / 96, cc = o % 96; float s = F.b_ada[slab * 96 + cc];
#pragma unroll
            for (int w = 0; w < NWAVES; ++w) s += red[(w * NB + j) * 96 + cc];
            F.mod[j * MODW + slab * 96 + cc] = s; }
        __syncthreads();
    }
}
DI void transpose_item(const float* W, int K, int N, bf16* WT, LAS float* scr, int item, int lane) {
    const int nblk = N / 32, kb = item / nblk, nb = item % nblk, k0 = 64 * kb, n0 = 32 * nb;
#pragma unroll 8
    for (int i = 0; i < 32; ++i) { const int kk = 2 * i + (lane >> 5); scr[kk * 33 + (lane & 31)] = W[(size_t)(k0 + kk) * N + n0 + (lane & 31)]; }
    LDS_WAIT(); asm volatile("" ::: "memory");
    const int c = lane & 7;
#pragma unroll
    for (int j = 0; j < 4; ++j) { const int n = (lane >> 3) + 8 * j; const LAS float* s = scr + (8 * c) * 33 + n;
        v4u o; o.x = pk2(s[0 * 33], s[1 * 33]); o.y = pk2(s[2 * 33], s[3 * 33]); o.z = pk2(s[4 * 33], s[5 * 33]); o.w = pk2(s[6 * 33], s[7 * 33]);
        *(GAS v4u*)(WT + (size_t)(n0 + n) * K + k0 + 8 * c) = o; }
    LDS_WAIT(); asm volatile("" ::: "memory");
}
DI void p0_prologue(Frame& F) {
    p0_mod(F);
    LAS float* scr = (LAS float*)(F.lds + F.wave * 8704);
    const int gw = F.vcu * NWAVES + F.wave, NGW = F.G * NWAVES;
    constexpr int I_IN = (D / 64) * (NIN / 32), I_OUT = (D / 64) * (D / 32);
    for (int it = gw; it < I_IN + I_OUT; it += NGW) {
        if (it < I_IN) transpose_item(F.w_in, D, NIN, F.Win_t, scr, it, F.lane);
        else transpose_item(F.w_out, D, D, F.Wout_t, scr, it - I_IN, F.lane);
    }
    { GAS v4u* z = (GAS v4u*)(F.Win_t + (size_t)NIN * D); const int nz = (LDP - NIN) * D * 2 / 16;
      for (int i = (F.vcu * NWAVES * 64) + F.tid; i < nz; i += F.G * NWAVES * 64) z[i] = (v4u){0u, 0u, 0u, 0u}; }
}
DI void p6_convert(Frame& F) {
    LAS float* scr = (LAS float*)(F.lds + F.wave * 8704);
    const int gw = F.vcu * NWAVES + F.wave, NGW = F.G * NWAVES;
    constexpr int I_MI = (D / 64) * (DFF / 32), I_MO = (DFF / 64) * (D / 32);
    for (int it = gw; it < I_MI + I_MO; it += NGW) {
        if (it < I_MI) transpose_item(F.w_mi, D, DFF, F.Wmi_t, scr, it, F.lane);
        else transpose_item(F.w_mo, DFF, D, F.Wmo_t, scr, it - I_MI, F.lane);
    }
}

template <int MODE> DI void norm_phase(Frame& F) {
    LAS float* P = (LAS float*)F.lds; LAS float* Q = P + D;
    const float* gvec = MODE == 0 ? F.norm1_g : (MODE == 1 ? F.norm2_g : F.final_g);
    constexpr int SC = MODE == 0 ? OFF_SC1 : OFF_SC2, SH = MODE == 0 ? OFF_SH1 : OFF_SH2;
    for (int rc = F.vcu; rc < T / 128; rc += F.G) {
        const int r0 = rc * 128, b = seq_of_row(r0);
        __syncthreads();
        for (int c4 = F.tid; c4 < D / 4; c4 += NWAVES * 64) {
            const f32x4 g = *(const f32x4*)(gvec + 4 * c4);
            if (MODE < 2) { const f32x4 sc = *(const f32x4*)(F.mod + b * MODW + SC + 4 * c4), sh = *(const f32x4*)(F.mod + b * MODW + SH + 4 * c4);
                *(LAS f32x4*)(P + 4 * c4) = g * (1.f + sc); *(LAS f32x4*)(Q + 4 * c4) = sh; }
            else *(LAS f32x4*)(P + 4 * c4) = g;
        }
        __syncthreads();
        for (int rr = F.wave; rr < 128; rr += NWAVES) {
            const int row = r0 + rr;
            const float* src = MODE == 0 ? (row < TP ? F.xp + (size_t)row * D : F.xs + (size_t)(row - TP) * D) : F.out + (size_t)row * D;
            f32x4 v[16]; float ss = 0.f;
#pragma unroll
            for (int j = 0; j < 16; ++j) { v[j] = *(const f32x4*)(src + 4 * (F.lane + 64 * j)); ss += (v[j][0] * v[j][0] + v[j][1] * v[j][1]) + (v[j][2] * v[j][2] + v[j][3] * v[j][3]); }
            const float rstd = 1.f / sqrtf(wave_sum(ss) * (1.f / D) + 1e-6f);
#pragma unroll
            for (int j = 0; j < 16; ++j) {
                const int c = 4 * (F.lane + 64 * j);
                const f32x4 p = *(const LAS f32x4*)(P + c);
                if (MODE < 2) { const f32x4 q = *(const LAS f32x4*)(Q + c); const f32x4 y = v[j] * rstd * p + q;
                    v2u w; w.x = pk2(y[0], y[1]); w.y = pk2(y[2], y[3]); *(GAS v2u*)(F.H + (size_t)row * D + c) = w; }
                else *(f32x4*)(F.out + (size_t)row * D + c) = v[j] * rstd * p;
            }
        }
    }
}

DI unsigned off_b(unsigned row, unsigned ch) { return 256u * row + 16u * (ch ^ (((row & 3u) << 2) | ((row >> 2) & 3u))); }
DI s16x4 tr_read(LAS unsigned char* p) { return __builtin_amdgcn_ds_read_tr16_b64_v4i16((LAS s16x4*)p); }
DI bf16x8 cat8(s16x4 a, s16x4 b) { return __builtin_shufflevector(a, b, 0, 1, 2, 3, 4, 5, 6, 7); }
template <int S> DI bf16x8 pack8(const f32x16& x) {
    v4u p; p.x = pk2(x[8 * S + 0], x[8 * S + 1]); p.y = pk2(x[8 * S + 2], x[8 * S + 3]); p.z = pk2(x[8 * S + 4], x[8 * S + 5]); p.w = pk2(x[8 * S + 6], x[8 * S + 7]);
    return __builtin_bit_cast(bf16x8, p);
}
DI int t5_bucket(int rel) {
    const int n = rel < 0 ? -rel : rel; int v;
    if (n < 8) v = n; else if (n < 12) v = 8; else if (n < 16) v = 9; else if (n < 23) v = 10; else if (n < 32) v = 11; else if (n < 46) v = 12; else if (n < 64) v = 13; else if (n < 91) v = 14; else v = 15;
    return (rel > 0 ? 16 : 0) + v;
}
constexpr int ATT_BT_OFF = 65536;
constexpr float LOG2E = 1.4426950408889634f;
constexpr float ATT_SCL = 0.08838834764831845f * 1.4426950408889634f;

DI void attn_item(Frame& F, int item) {
    LAS unsigned char* lds = F.lds;
    const LAS float* btab = (const LAS float*)(F.lds + ATT_BT_OFF);
    const int kvh = item & 3, sq = item >> 2;
    int seq, qh; if (sq < 256) { seq = sq >> 5; qh = sq & 31; } else { seq = 8 + ((sq - 256) >> 6); qh = (sq - 256) & 63; }
    const int S_len = seq_len(seq), base = seq_base(seq);
    const int head = 4 * kvh + (F.wave >> 1), r = F.lane & 31, hh = F.lane >> 5;
    const int qpos = 64 * qh + 32 * (F.wave & 1) + r, qrow = base + qpos;
    bf16x8 qf[8];
    { const bf16* qp = F.PROJ + (size_t)qrow * LDP + C_QA + head * 128 + 8 * hh;
#pragma unroll
      for (int ks = 0; ks < 8; ++ks) qf[ks] = *(const bf16x8*)(qp + 16 * ks); }
    const int tlo = qh >= 2 ? 0 : 2 - qh; int thi = S_len / 64 - qh + 1; if (thi > 4) thi = 4;
    float m = F.sink[head] * LOG2E, l = hh == 0 ? 1.f : 0.f;
    f32x16 o[4];
#pragma unroll
    for (int c = 0; c < 4; ++c)
#pragma unroll
        for (int i = 0; i < 16; ++i) o[c][i] = 0.f;
    v4u kreg[2], vreg[2];
    const int srow = F.tid >> 4, sch = F.tid & 15;
    const bf16* kvp = F.PROJ + (ptrdiff_t)(base + 64 * qh - 128 + srow) * LDP + kvh * 128 + sch * 8;
#define ATT_PREFETCH(t) do { _Pragma("unroll") for (int i_ = 0; i_ < 2; ++i_) { const bf16* p_ = kvp + (ptrdiff_t)(64 * (t) + 32 * i_) * LDP; \
        kreg[i_] = *(const GAS v4u*)(p_ + C_KA); vreg[i_] = *(const GAS v4u*)(p_ + C_VA); } } while (0)
    ATT_PREFETCH(tlo);
    const int i16 = F.lane & 15, q4 = i16 >> 2, p4 = i16 & 3, blk = (F.lane >> 4) & 1;
    for (int t = tlo; t <= thi; ++t) {
        const int buf = (t - tlo) & 1;
        LAS unsigned char* Kb = lds + buf * 16384; LAS unsigned char* Vb = lds + 32768 + buf * 16384;
#pragma unroll
        for (int i = 0; i < 2; ++i) { const unsigned a = off_b(srow + 32 * i, sch); *(LAS v4u*)(Kb + a) = kreg[i]; *(LAS v4u*)(Vb + a) = vreg[i]; }
        if (t < thi) ATT_PREFETCH(t + 1);
        __syncthreads();
        const int key0 = 64 * qh - 128 + 64 * t;
        f32x16 st[2];
#pragma unroll
        for (int kt = 0; kt < 2; ++kt) {
#pragma unroll
            for (int i = 0; i < 16; ++i) st[kt][i] = 0.f;
#pragma unroll
            for (int ks = 0; ks < 8; ++ks) { const bf16x8 ka = *(const LAS bf16x8*)(Kb + 8192 * kt + off_b(r, 2 * ks + hh)); st[kt] = MFMA32(ka, qf[ks], st[kt]); }
        }
        const LAS float* bt = btab + head * 384 + (key0 - qpos + 4 * hh + 192);
        float mx = -3.0e38f;
#pragma unroll
        for (int kt = 0; kt < 2; ++kt)
#pragma unroll
            for (int i = 0; i < 16; ++i) { const float tv = st[kt][i] * ATT_SCL + bt[32 * kt + (i & 3) + 8 * (i >> 2)]; st[kt][i] = tv; mx = fmaxf(mx, tv); }
        mx = fmaxf(mx, __shfl_xor(mx, 32));
        const float mn = fmaxf(m, mx), alpha = __builtin_amdgcn_exp2f(m - mn); m = mn;
        float ls = 0.f;
#pragma unroll
        for (int kt = 0; kt < 2; ++kt)
#pragma unroll
            for (int i = 0; i < 16; ++i) { const float p = __builtin_amdgcn_exp2f(st[kt][i] - mn); st[kt][i] = p; ls += p; }
        l = l * alpha + ls;
#pragma unroll
        for (int c = 0; c < 4; ++c)
#pragma unroll
            for (int i = 0; i < 16; ++i) o[c][i] *= alpha;
#pragma unroll
        for (int s = 0; s < 4; ++s) {
            const bf16x8 pb = (s & 1) ? pack8<1>(st[s >> 1]) : pack8<0>(st[s >> 1]);
#pragma unroll
            for (int c = 0; c < 4; ++c) {
                const unsigned a0 = off_b(16 * s + 4 * hh + q4, 4 * c + 2 * blk + (p4 >> 1)) + 8 * (p4 & 1);
                const unsigned a1 = off_b(16 * s + 8 + 4 * hh + q4, 4 * c + 2 * blk + (p4 >> 1)) + 8 * (p4 & 1);
                const bf16x8 va = cat8(tr_read(Vb + a0), tr_read(Vb + a1));
                o[c] = MFMA32(va, pb, o[c]);
            }
        }
    }
#undef ATT_PREFETCH
    l += __shfl_xor(l, 32);
    const float inv = 1.f / l;
    bf16* op = F.MIX + (size_t)qrow * D + head * 128 + 4 * hh;
#pragma unroll
    for (int c = 0; c < 4; ++c)
#pragma unroll
        for (int g = 0; g < 4; ++g) { v2u w; w.x = pk2(o[c][4 * g] * inv, o[c][4 * g + 1] * inv); w.y = pk2(o[c][4 * g + 2] * inv, o[c][4 * g + 3] * inv);
            *(GAS v2u*)(op + 32 * c + 8 * g) = w; }
    __syncthreads();
}

constexpr int GL_QT = 0, GL_KT = 8192, GL_KD = 16384, GL_V = 24576, GL_AT = 57344, GL_TOT = 59392, GL_DEC = 63488;
DI void gla_item(Frame& F, int item) {
    LAS unsigned char* lds = F.lds;
    int seq, rem; if (item < 64) { seq = 8 + (item >> 4); rem = item & 15; } else { seq = (item - 64) >> 4; rem = (item - 64) & 15; }
    const int hd = rem >> 1, dir = rem & 1;
    const int S_len = seq_len(seq), base = seq_base(seq), nchunk = S_len / 32;
    const float* wa = dir ? F.wa_b : F.wa_f; const float* ba = dir ? F.ba_b : F.ba_f;
    const int acol = dir ? C_AB : C_AF; bf16* obuf = dir ? F.OB : F.OF;
    const int lane = F.lane, wave = F.wave; const unsigned r_ = lane & 31, hh_ = lane >> 5, q4_ = (lane & 15) >> 2, p4_ = lane & 3, blk_ = (lane >> 4) & 1;
    f32x2 wav[16];
#pragma unroll
    for (int j = 0; j < 16; ++j) wav[j] = *(const f32x2*)(wa + j * 1024 + hd * 128 + 2 * lane);
    const f32x2 bav = *(const f32x2*)(ba + hd * 128 + 2 * lane);
    f32x16 St[4];
#pragma unroll
    for (int kt = 0; kt < 4; ++kt)
#pragma unroll
        for (int i = 0; i < 16; ++i) St[kt][i] = 0.f;
    unsigned qv[4], kv[4]; v4u vv[2]; v4u av = (v4u){0u, 0u, 0u, 0u};
    const int vrow = F.tid >> 5, vch = F.tid & 31;
#define GLA_PREFETCH(n) do { const int p0_ = dir ? S_len - 32 * ((n) + 1) : 32 * (n); \
        _Pragma("unroll") for (int i_ = 0; i_ < 4; ++i_) { const int c_ = 4 * wave + i_, orow_ = dir ? 31 - c_ : c_; \
            const bf16* p_ = F.PROJ + (size_t)(base + p0_ + orow_) * LDP + hd * 128 + 2 * lane; qv[i_] = *(const GAS unsigned*)(p_ + C_QG); kv[i_] = *(const GAS unsigned*)(p_ + C_KG); } \
        _Pragma("unroll") for (int i_ = 0; i_ < 2; ++i_) vv[i_] = *(const GAS v4u*)(F.PROJ + (size_t)(base + p0_ + vrow + 16 * i_) * LDP + C_VG + hd * 256 + vch * 8); \
        if (F.tid < 64) av = *(const GAS v4u*)(F.PROJ + (size_t)(base + p0_ + (F.tid >> 1)) * LDP + acol + (F.tid & 1) * 8); } while (0)
    GLA_PREFETCH(0);
    LAS unsigned char* Vimg0 = lds + GL_V + (wave >> 2) * 8192; const int cV = wave & 3;
    for (int n = 0; n < nchunk; ++n) {
        const int p0 = dir ? S_len - 32 * (n + 1) : 32 * n;
        LAS unsigned char* Vb = lds + GL_V + (n & 1) * 16384;
#pragma unroll
        for (int i = 0; i < 2; ++i) { const int srow = vrow + 16 * i, c = dir ? 31 - srow : srow; *(LAS v4u*)(Vb + (vch >> 4) * 8192 + off_b(c, vch & 15)) = vv[i]; }
        if (F.tid < 64) { const int srow = F.tid >> 1, c = dir ? 31 - srow : srow; LAS float* ap = (LAS float*)(lds + GL_AT) + c * 16 + (F.tid & 1) * 8;
            *(LAS f32x4*)ap = (f32x4){bf_lo(av.x), bf_hi(av.x), bf_lo(av.y), bf_hi(av.y)}; *(LAS f32x4*)(ap + 4) = (f32x4){bf_lo(av.z), bf_hi(av.z), bf_lo(av.w), bf_hi(av.w)}; }
        __syncthreads();
        f32x2 cum[4];
#pragma unroll
        for (int i = 0; i < 4; ++i) {
            const LAS float* ap = (const LAS float*)(lds + GL_AT) + (4 * wave + i) * 16;
            f32x2 x = bav;
#pragma unroll
            for (int j4 = 0; j4 < 4; ++j4) { const f32x4 a = *(const LAS f32x4*)(ap + 4 * j4);
                x += a[0] * wav[4 * j4] + a[1] * wav[4 * j4 + 1] + a[2] * wav[4 * j4 + 2] + a[3] * wav[4 * j4 + 3]; }
            f32x2 lg;
            lg[0] = (fminf(x[0], 0.f) - __logf(1.f + __expf(-fabsf(x[0])))) * 0.0625f;
            lg[1] = (fminf(x[1], 0.f) - __logf(1.f + __expf(-fabsf(x[1])))) * 0.0625f;
            cum[i] = i ? cum[i - 1] + lg : lg;
        }
        *(LAS f32x2*)((LAS float*)(lds + GL_TOT) + wave * 128 + 2 * lane) = cum[3];
        __syncthreads();
        f32x2 pre = (f32x2){0.f, 0.f}, tot = (f32x2){0.f, 0.f};
#pragma unroll
        for (int w = 0; w < 8; ++w) { const f32x2 tw = *(const LAS f32x2*)((const LAS float*)(lds + GL_TOT) + w * 128 + 2 * lane); if (w < wave) pre += tw; tot += tw; }
#pragma unroll
        for (int i = 0; i < 4; ++i) {
            const int c = 4 * wave + i; const f32x2 b = pre + cum[i];
            const float eb0 = __expf(b[0]), eb1 = __expf(b[1]), en0 = __expf(-b[0]), en1 = __expf(-b[1]), ed0 = __expf(tot[0] - b[0]), ed1 = __expf(tot[1] - b[1]);
            const float q0 = bf_lo(qv[i]) * 0.08838834764831845f, q1 = bf_hi(qv[i]) * 0.08838834764831845f, k0 = bf_lo(kv[i]), k1 = bf_hi(kv[i]);
            const unsigned a = off_b(c, lane >> 2) + 4 * (lane & 3);
            *(LAS unsigned*)(lds + GL_QT + a) = pk2(q0 * eb0, q1 * eb1);
            *(LAS unsigned*)(lds + GL_KT + a) = pk2(k0 * en0, k1 * en1);
            *(LAS unsigned*)(lds + GL_KD + a) = pk2(k0 * ed0, k1 * ed1);
        }
        if (wave == 0) *(LAS f32x2*)((LAS float*)(lds + GL_DEC) + 2 * lane) = (f32x2){__expf(tot[0]), __expf(tot[1])};
        if (n + 1 < nchunk) GLA_PREFETCH(n + 1);
        __syncthreads();
        unsigned r = r_, hh = hh_, q4 = q4_, p4 = p4_, blk = blk_;
        asm volatile("" : "+v"(r), "+v"(hh), "+v"(q4), "+v"(p4), "+v"(blk));
        LAS unsigned char* Vi = Vb + (wave >> 2) * 8192;
        f32x16 at;
#pragma unroll
        for (int i = 0; i < 16; ++i) at[i] = 0.f;
#pragma unroll
        for (int ks = 0; ks < 8; ++ks) { const unsigned a = off_b(r, 2 * ks + hh);
            at = MFMA32(*(const LAS bf16x8*)(lds + GL_KT + a), *(const LAS bf16x8*)(lds + GL_QT + a), at); }
#pragma unroll
        for (int i = 0; i < 16; ++i) if ((unsigned)((i & 3) + 8 * (i >> 2)) + 4 * hh > r) at[i] = 0.f;
        f32x16 o;
#pragma unroll
        for (int i = 0; i < 16; ++i) o[i] = 0.f;
#pragma unroll
        for (int kt = 0; kt < 4; ++kt) {
            { const bf16x8 qa = cat8(*(const LAS s16x4*)(lds + GL_QT + off_b(r, 4 * kt + 0) + 8 * hh), *(const LAS s16x4*)(lds + GL_QT + off_b(r, 4 * kt + 1) + 8 * hh));
              o = MFMA32(qa, pack8<0>(St[kt]), o); }
            { const bf16x8 qa = cat8(*(const LAS s16x4*)(lds + GL_QT + off_b(r, 4 * kt + 2) + 8 * hh), *(const LAS s16x4*)(lds + GL_QT + off_b(r, 4 * kt + 3) + 8 * hh));
              o = MFMA32(qa, pack8<1>(St[kt]), o); }
        }
        {
            const unsigned cc = 4 * cV + 2 * blk + (p4 >> 1), po = 8 * (p4 & 1);
            const bf16x8 v0 = cat8(tr_read(Vi + off_b(0 + 4 * hh + q4, cc) + po), tr_read(Vi + off_b(8 + 4 * hh + q4, cc) + po));
            o = MFMA32(pack8<0>(at), v0, o);
            const bf16x8 v1 = cat8(tr_read(Vi + off_b(16 + 4 * hh + q4, cc) + po), tr_read(Vi + off_b(24 + 4 * hh + q4, cc) + po));
            o = MFMA32(pack8<1>(at), v1, o);
        }
        {
            bf16* op = obuf + (size_t)(base + p0) * 2048 + hd * 256 + 32 * wave + r;
#pragma unroll
            for (int i = 0; i < 16; ++i) { const int c = (i & 3) + 8 * (i >> 2) + 4 * (int)hh, orow = dir ? 31 - c : c; op[(size_t)orow * 2048] = (bf16)(pk2(o[i], 0.f) & 0xffffu); }
        }
        {
            const unsigned cc = 4 * cV + 2 * blk + (p4 >> 1), po = 8 * (p4 & 1);
            const bf16x8 vb0 = cat8(tr_read(Vi + off_b(0 + 8 * hh + q4, cc) + po), tr_read(Vi + off_b(4 + 8 * hh + q4, cc) + po));
            const bf16x8 vb1 = cat8(tr_read(Vi + off_b(16 + 8 * hh + q4, cc) + po), tr_read(Vi + off_b(20 + 8 * hh + q4, cc) + po));
#pragma unroll
            for (int kt = 0; kt < 4; ++kt) {
                const LAS float* dp = (const LAS float*)(lds + GL_DEC) + 32 * kt + 4 * hh;
#pragma unroll
                for (int g = 0; g < 4; ++g) { const f32x4 d = *(const LAS f32x4*)(dp + 8 * g);
                    St[kt][4 * g] *= d[0]; St[kt][4 * g + 1] *= d[1]; St[kt][4 * g + 2] *= d[2]; St[kt][4 * g + 3] *= d[3]; }
                const unsigned ck = 4 * kt + 2 * blk + (p4 >> 1);
                const bf16x8 ka0 = cat8(tr_read(lds + GL_KD + off_b(0 + 8 * hh + q4, ck) + po), tr_read(lds + GL_KD + off_b(4 + 8 * hh + q4, ck) + po));
                St[kt] = MFMA32(ka0, vb0, St[kt]);
                const bf16x8 ka1 = cat8(tr_read(lds + GL_KD + off_b(16 + 8 * hh + q4, ck) + po), tr_read(lds + GL_KD + off_b(20 + 8 * hh + q4, ck) + po));
                St[kt] = MFMA32(ka1, vb1, St[kt]);
            }
        }
    }
#undef GLA_PREFETCH
    (void)Vimg0;
    __syncthreads();
}

DI void p3_mixers(Frame& F) {
    { LAS float* bt = (LAS float*)(F.lds + ATT_BT_OFF);
      for (int idx = F.tid; idx < 16 * 384; idx += NWAVES * 64) { const int h = idx / 384, rel = idx % 384 - 192;
          bt[idx] = (rel >= -128 && rel <= 128) ? F.rel_bias[t5_bucket(rel) * 16 + h] * LOG2E : -1.0e30f; } }
    __syncthreads();
#ifndef NO_GLA
    for (int item = F.vcu; item < 192; item += F.G) gla_item(F, item);
#endif
    for (;;) {
        if (F.tid == 0) F.MISC[0] = __hip_atomic_fetch_add((unsigned*)(F.ctl + CW_QUEUE), 1u, RLX_AGENT);
        __syncthreads();
        const int it = (int)F.MISC[0];
        __syncthreads();
        if (it >= 2048) break;
#ifndef NO_ATT
        attn_item(F, it);
#endif
    }
}

DI void p4_combine(Frame& F) {
    const int gw = F.vcu * NWAVES + F.wave, NGW = F.G * NWAVES;
    const int hd = F.lane >> 3, part = F.lane & 7, voff = hd * 256 + part * 32;
    f32x4 gn[8];
#pragma unroll
    for (int j = 0; j < 8; ++j) gn[j] = *(const f32x4*)(F.gla_norm_g + part * 32 + 4 * j);
    for (int row = gw; row < T; row += NGW) {
        const GAS v4u* pf = (const GAS v4u*)(F.OF + (size_t)row * 2048 + voff);
        const GAS v4u* pb = (const GAS v4u*)(F.OB + (size_t)row * 2048 + voff);
        const GAS v4u* pr = (const GAS v4u*)(F.PROJ + (size_t)row * LDP + C_RG + voff);
        float o[32]; float ss = 0.f; v4u rg[4];
#pragma unroll
        for (int j = 0; j < 4; ++j) { const v4u a = pf[j], b = pb[j]; rg[j] = pr[j];
#pragma unroll
            for (int e = 0; e < 4; ++e) { const float x0 = bf_lo(a[e]) + bf_lo(b[e]), x1 = bf_hi(a[e]) + bf_hi(b[e]); o[8 * j + 2 * e] = x0; o[8 * j + 2 * e + 1] = x1; ss += x0 * x0 + x1 * x1; } }
        ss += __shfl_xor(ss, 1); ss += __shfl_xor(ss, 2); ss += __shfl_xor(ss, 4);
        const float rstd = 1.f / sqrtf(ss * (1.f / 256.f) + 1e-6f);
        GAS v4u* po = (GAS v4u*)(F.MIX + (size_t)row * D + 2048 + voff);
#pragma unroll
        for (int j = 0; j < 4; ++j) { v4u w;
#pragma unroll
            for (int e = 0; e < 4; ++e) { const float g0 = bf_lo(rg[j][e]), g1 = bf_hi(rg[j][e]);
                const float y0 = o[8 * j + 2 * e] * rstd * gn[2 * j + (e >> 1)][(2 * e) & 3] * (g0 / (1.f + __expf(-g0)));
                const float y1 = o[8 * j + 2 * e + 1] * rstd * gn[2 * j + (e >> 1)][(2 * e + 1) & 3] * (g1 / (1.f + __expf(-g1)));
                w[e] = pk2(y0, y1); }
            po[j] = w; }
    }
}

struct Args { const float* in[20]; float* out; unsigned char* ws; int ph_lo, ph_hi; };
__global__ void __launch_bounds__(NWAVES * 64, 2) fwd_kernel(Args args) {
    extern __shared__ __attribute__((aligned(16))) unsigned char lds[];
    Frame F;
    F.lds = (LAS unsigned char*)lds;
    F.MISC = (volatile LAS unsigned*)(F.lds + MISC_OFF);
    F.tid = threadIdx.x; F.lane = F.tid & 63; F.wave = __builtin_amdgcn_readfirstlane(F.tid >> 6);
    F.G = gridDim.x; { const int bx = blockIdx.x; F.vcu = (F.G % 8 == 0) ? (bx % 8) * (F.G / 8) + bx / 8 : bx; }
    unsigned char* ws = args.ws;
    F.ctl = (gu32*)(ws + WS_CTL);
    F.xp = args.in[0]; F.xs = args.in[1]; F.cp = args.in[2]; F.cs = args.in[3]; F.w_ada = args.in[4]; F.b_ada = args.in[5]; F.norm1_g = args.in[6]; F.w_in = args.in[7];
    F.wa_f = args.in[8]; F.ba_f = args.in[9]; F.wa_b = args.in[10]; F.ba_b = args.in[11]; F.gla_norm_g = args.in[12]; F.sink = args.in[13]; F.rel_bias = args.in[14];
    F.w_out = args.in[15]; F.norm2_g = args.in[16]; F.w_mi = args.in[17]; F.w_mo = args.in[18]; F.final_g = args.in[19];
    F.out = args.out; F.mod = (float*)(ws + WS_MOD);
    F.Win_t = (bf16*)(ws + WS_WIN); F.Wout_t = (bf16*)(ws + WS_WOUT); F.Wmi_t = (bf16*)(ws + WS_WMI); F.Wmo_t = (bf16*)(ws + WS_WMO);
    F.H = (bf16*)(ws + WS_H); F.PROJ = (bf16*)(ws + WS_PROJ); F.MIX = (bf16*)(ws + WS_MIX); F.OF = (bf16*)(ws + WS_OF); F.OB = (bf16*)(ws + WS_OB);
    F.HID0 = (bf16*)(ws + WS_HID0); F.HID1 = (bf16*)(ws + WS_HID1);
    for (int u = F.tid; u < (LDS_BYTES - LDSCTL_OFF) / 4; u += NWAVES * 64) ((LAS unsigned*)(F.lds + LDSCTL_OFF))[u] = 0u;
    __syncthreads();
    XcdBarrier bar; bar.bar = (unsigned*)(F.ctl + CW_BAR); bar.x = 0; bar.st = nullptr;
    if (MK_ONE_LAUNCH) bar = xcd_barrier_post((unsigned*)(F.ctl + CW_BAR), F.MISC + 8);
    const int lo = args.ph_lo, hi = args.ph_hi;
#ifndef PH_MASK
#define PH_MASK 0xffff
#endif
#define IN(k) ((((PH_MASK) >> (k)) & 1) && lo <= (k) && (k) < hi)
#define SEAM(k) do { if (IN(k) && IN((k) + 1)) xcd_barrier(bar); } while (0)

    if (IN(0)) { p0_prologue(F); SEAM(0); }
    if (IN(1)) { norm_phase<0>(F); SEAM(1); }
    if (IN(2)) {
        pg8::Gemm g{F.H, F.Win_t, T, LDP, D}; pg8::StaticOrder S; S.init(T, LDP, F.G, (int)blockIdx.x);
        pg8::EpiBf16<0> E{F.PROJ, LDP};
        pg8::gemm_phase<pg8::EpiBf16<0>, pg8::StaticOrder, PG8_ALIGN, PG8_SP2>(F.lds + RING_OFF, g, S, E);
        SEAM(2);
    }
    if (IN(3)) { p3_mixers(F); SEAM(3); }
    if (IN(4)) { p4_combine(F); SEAM(4); }
    if (IN(5)) {
        pg8::Gemm g{F.MIX, F.Wout_t, T, D, D}; pg8::StaticOrder S; S.init(T, D, F.G, (int)blockIdx.x);
        pg8::EpiResid E{F.xp, F.xs, F.out, F.mod, OFF_G1, 0};
        pg8::gemm_phase<pg8::EpiResid, pg8::StaticOrder, PG8_ALIGN, PG8_SP2>(F.lds + RING_OFF, g, S, E);
        SEAM(5);
    }
    if (IN(6)) { norm_phase<1>(F); __syncthreads(); p6_convert(F); SEAM(6); }
#pragma unroll
    for (int c = 0; c < MLP_CH; ++c) {
        bf16* hid = (c & 1) ? F.HID1 : F.HID0;
        if (IN(7 + 2 * c)) {
            pg8::Gemm g{F.H + (size_t)c * MLP_ROWS * D, F.Wmi_t, MLP_ROWS, DFF, D}; pg8::StaticOrder S; S.init(MLP_ROWS, DFF, F.G, (int)blockIdx.x);
            pg8::EpiBf16<1> E{hid, DFF};
            pg8::gemm_phase<pg8::EpiBf16<1>, pg8::StaticOrder, PG8_ALIGN, PG8_SP2>(F.lds + RING_OFF, g, S, E);
            SEAM(7 + 2 * c);
        }
        if (IN(8 + 2 * c)) {
            pg8::Gemm g{hid, F.Wmo_t, MLP_ROWS, D, DFF}; pg8::StaticOrder S; S.init(MLP_ROWS, D, F.G, (int)blockIdx.x);
            pg8::EpiResid E{F.out, F.out + (size_t)TP * D, F.out, F.mod, OFF_G2, c * MLP_ROWS};
            pg8::gemm_phase<pg8::EpiResid, pg8::StaticOrder, PG8_ALIGN, PG8_SP2>(F.lds + RING_OFF, g, S, E);
            if (c == MLP_CH - 1) SEAM(8 + 2 * c);
        }
    }
    if (IN(15)) norm_phase<2>(F);
#undef IN
#undef SEAM
}

extern "C" void kernel_launch(void* const* d_in, const int* in_sizes, int n_in, void* d_out, int out_size, void* d_ws, size_t ws_size, hipStream_t stream) {
    static int grid = 0;
    if (grid == 0) {
        if (n_in != 20 || out_size != T * D || ws_size < WS_END) { fprintf(stderr, "kernel_launch: unexpected shapes (n_in %d, out %d, ws %zu < %zu); nothing launched\n", n_in, out_size, ws_size, (size_t)WS_END); grid = -1; return; }
        int dev = 0, cus = 0, per_cu = 0;
        if (hipGetDevice(&dev) != hipSuccess || hipDeviceGetAttribute(&cus, hipDeviceAttributeMultiprocessorCount, dev) != hipSuccess) { grid = -1; return; }
        if (hipFuncSetAttribute((const void*)fwd_kernel, hipFuncAttributeMaxDynamicSharedMemorySize, LDS_BYTES) != hipSuccess) { fprintf(stderr, "kernel_launch: hipFuncSetAttribute failed\n"); grid = -1; return; }
        if (hipOccupancyMaxActiveBlocksPerMultiprocessor(&per_cu, (const void*)fwd_kernel, NWAVES * 64, LDS_BYTES) != hipSuccess || per_cu < 1)
            fprintf(stderr, "kernel_launch: note: occupancy query reports %d workgroups per CU\n", per_cu);
        (void)hipGetLastError();
        grid = cus;
    }
    if (grid < 0) return;
    if (hipMemsetAsync((char*)d_ws + WS_CTL, 0, CTL_ZERO_BYTES, stream) != hipSuccess) return;
    Args a{};
    for (int i = 0; i < 20; ++i) a.in[i] = (const float*)d_in[i];
    a.out = (float*)d_out; a.ws = (unsigned char*)d_ws;
#if MK_ONE_LAUNCH
    a.ph_lo = 0; a.ph_hi = N_PHASES;
    hipLaunchKernelGGL(fwd_kernel, dim3(grid), dim3(NWAVES * 64), LDS_BYTES, stream, a);
#else
    for (int p = 0; p < N_PHASES; ++p) { a.ph_lo = p; a.ph_hi = p + 1; hipLaunchKernelGGL(fwd_kernel, dim3(grid), dim3(NWAVES * 64), LDS_BYTES, stream, a); }
#endif
    const hipError_t le = hipPeekAtLastError();
    if (le != hipSuccess) fprintf(stderr, "kernel_launch: launch failed: %s\n", hipGetErrorName(le));
}
```

```cpp
#include <hip/hip_runtime.h>
#include <cstdio>
#include <cstdint>
namespace pg8 {
#define PG8_LAS __attribute__((address_space(3)))
typedef unsigned short bf16_t;
typedef short bf16x8 __attribute__((ext_vector_type(8)));
typedef float f32x4 __attribute__((ext_vector_type(4)));
typedef unsigned u32x4 __attribute__((ext_vector_type(4)));
constexpr int BM = 256, BK = 64, HALF = 128, HTB = HALF * BK * 2  , STAGE_BYTES = 8 * HTB, NXCD = 8, WGM = 8;

__host__ __device__ __forceinline__ int lds_byte(int r, int c) { const int st = (r >> 4) * 2 + (c >> 5), rr = r & 15, cc = c & 31, ob = rr * 64 + cc * 2; return st * 1024 + (ob ^ (((ob >> 9) & 1) << 5)); }
__host__ __device__ __forceinline__ void stage_rc(int b, int& R, int& C) { const int st = b / 1024, sb = b % 1024, swz = sb ^ (((sb >> 9) & 1) << 5); R = (st >> 1) * 16 + swz / 64; C = (st & 1) * 32 + (swz % 64) / 2; }
__host__ __device__ __forceinline__ int perm32(int rho) { const int n = rho >> 4, i = rho & 15; return 8 * (i >> 2) + 4 * n + (i & 3); }

struct Unit { int pm, pn; };
struct Gemm { const bf16_t* A; const bf16_t* Bt; int M, N, K; };

struct StaticOrder {
    int nM, nN, nwg, G, c;
    __host__ __device__ void init(int M, int N, int G_, int c_) { nM = M / BM; nN = N / BM; nwg = nM * nN; G = G_; c = c_; }
    __host__ __device__ bool next(int i, Unit& u) const {
        const long L = (long)i * G + c; if (L >= nwg) return false;
        int wgid = (int)L; { const int q = nwg / NXCD, r = nwg % NXCD, xcd = wgid % NXCD, off = wgid / NXCD; wgid = (xcd < r ? xcd * (q + 1) : r * (q + 1) + (xcd - r) * q) + off; }
        const int nig = WGM * nN, gid = wgid / nig, fm = gid * WGM, gsz = (nM - fm) < WGM ? (nM - fm) : WGM;
        u.pm = fm + ((wgid % nig) % gsz); u.pn = (wgid % nig) / gsz; return true;
    }
    __device__ __forceinline__ void a_ready(const Unit&) const {}
    __device__ __forceinline__ void done(const Unit&) const {}
};


typedef float f32x2 __attribute__((ext_vector_type(2)));
typedef __bf16 bf16v2 __attribute__((ext_vector_type(2)));
__device__ __forceinline__ unsigned cvt_pk_bf16(float lo, float hi) { const f32x2 v = {lo, hi}; return __builtin_bit_cast(unsigned, __builtin_convertvector(v, bf16v2)); }

template <int ACT  > struct EpiBf16 {
    static constexpr bool PERM = true, AFTER_DRAIN = false;
    bf16_t* O; int ldc;
    __device__ __forceinline__ void operator()(const f32x4 (&acc)[2][2][4][2], const Unit& u, int wr, int wc, int fr, int fq) const {
        const int row0 = u.pm * BM + wr * 64 + fr, col0 = u.pn * BM + wc * 32 + 8 * fq;
#pragma unroll
        for (int ai = 0; ai < 2; ++ai)
#pragma unroll
            for (int m = 0; m < 4; ++m) { bf16_t* rowp = O + (size_t)(row0 + ai * HALF + m * 16) * ldc + col0;
#pragma unroll
                for (int bj = 0; bj < 2; ++bj) { f32x4 v0 = acc[ai][bj][m][0], v1 = acc[ai][bj][m][1];
                    if (ACT == 1) {
#pragma unroll
                        for (int j = 0; j < 4; ++j) { const float a = fmaxf(v0[j], 0.f), b = fmaxf(v1[j], 0.f); v0[j] = a * a; v1[j] = b * b; } }
                    u32x4 w; w.x = cvt_pk_bf16(v0[0], v0[1]); w.y = cvt_pk_bf16(v0[2], v0[3]); w.z = cvt_pk_bf16(v1[0], v1[1]); w.w = cvt_pk_bf16(v1[2], v1[3]);
                    *(u32x4*)(rowp + bj * HALF) = w; } }
    }
};

#ifndef PROBE_CONTIG
#define PROBE_CONTIG 0
#endif
struct EpiBf16Probe {
    static constexpr bool PERM = true, AFTER_DRAIN = false;
    bf16_t* O; int ldc; int skip_after; mutable int calls; bf16_t* O2;
    __device__ __forceinline__ void operator()(const f32x4 (&acc)[2][2][4][2], const Unit& u, int wr, int wc, int fr, int fq) const {
        if (calls++ >= skip_after) {
#if PROBE_CONTIG
            const int wave = wr * 4 + wc, lane = fq * 16 + fr;
            bf16_t* base = O2 + (size_t)((u.pm * 37 + u.pn) & 2047) * 65536;
#pragma unroll
            for (int ai = 0; ai < 2; ++ai)
#pragma unroll
                for (int m = 0; m < 4; ++m)
#pragma unroll
                    for (int bj = 0; bj < 2; ++bj) { const f32x4 v0 = acc[ai][bj][m][0], v1 = acc[ai][bj][m][1];
                        u32x4 w; w.x = cvt_pk_bf16(v0[0], v0[1]); w.y = cvt_pk_bf16(v0[2], v0[3]); w.z = cvt_pk_bf16(v1[0], v1[1]); w.w = cvt_pk_bf16(v1[2], v1[3]);
                        *(u32x4*)(base + ((((ai * 4 + m) * 2 + bj) * 8 + wave) * 64 + lane) * 8) = w; }
#else
#pragma unroll
            for (int ai = 0; ai < 2; ++ai)
#pragma unroll
                for (int bj = 0; bj < 2; ++bj)
#pragma unroll
                    for (int m = 0; m < 4; ++m)
#pragma unroll
                        for (int n = 0; n < 2; ++n) asm volatile("" :: "v"(acc[ai][bj][m][n]));
#endif
            return; }
        EpiBf16<0> E{O, ldc}; E(acc, u, wr, wc, fr, fq);
    }
};
struct EpiResid {
    static constexpr bool PERM = false, AFTER_DRAIN = false;
    const float* xp; const float* xs; float* out; const float* mod; int goff; int row_base;
    __device__ __forceinline__ void operator()(const f32x4 (&acc)[2][2][4][2], const Unit& u, int wr, int wc, int fr, int fq) const {
        const int R0 = row_base + u.pm * BM;
        const int b = R0 < 16384 ? (R0 >> 11) : 8 + ((R0 - 16384) >> 12);
        const float* src = R0 < 16384 ? xp + (size_t)R0 * 4096 : xs + (size_t)(R0 - 16384) * 4096;
        float* dst = out + (size_t)R0 * 4096;
        const float* gate = mod + b * 24576 + goff;
        const int rl = wr * 64 + fr, col0 = u.pn * BM + wc * 32 + 4 * fq;
        f32x4 gv[2][2];
#pragma unroll
        for (int bj = 0; bj < 2; ++bj)
#pragma unroll
            for (int n = 0; n < 2; ++n) gv[bj][n] = *(const f32x4*)(gate + col0 + bj * HALF + n * 16);
#pragma unroll
        for (int ai = 0; ai < 2; ++ai)
#pragma unroll
            for (int m = 0; m < 4; ++m) { const size_t off = (size_t)(rl + ai * HALF + m * 16) * 4096 + col0;
#pragma unroll
                for (int bj = 0; bj < 2; ++bj)
#pragma unroll
                    for (int n = 0; n < 2; ++n) { const f32x4 s = *(const f32x4*)(src + off + bj * HALF + n * 16);
                        *(f32x4*)(dst + off + bj * HALF + n * 16) = s + gv[bj][n] * acc[ai][bj][m][n]; } }
    }
};

template <class Epi, class Sched, bool ALIGN_EPI = false, bool SP2 = false>
__device__ __forceinline__ void gemm_phase(PG8_LAS unsigned char* lds, const Gemm g, const Sched& S, const Epi& E) {
    const int tid = threadIdx.x, wid = __builtin_amdgcn_readfirstlane(tid >> 6), lane = tid & 63, wr = wid >> 2, wc = wid & 3, fr = lane & 15, fq = lane >> 4;
    const int K = g.K, nt = K / BK;
    unsigned voffA[2], voffB[2];
#pragma unroll
    for (int i = 0; i < 2; ++i) { int R, C; stage_rc(tid * 16 + i * 8192, R, C); const int Rb = Epi::PERM ? ((R & ~31) + perm32(R & 31)) : R;
        voffA[i] = (unsigned)(R * K + C) * 2u; voffB[i] = (unsigned)(Rb * K + C) * 2u; }
    const size_t kstep = (size_t)(BK * 2);
    const size_t hstep = (size_t)HALF * K * 2;
    const size_t tstep = 2 * hstep;
    const unsigned ldsw = (unsigned)wid * 1024u;
    const int aoff = lds_byte(wr * 64 + fr, fq * 8), boff = lds_byte(wc * 32 + fr, fq * 8);
#define PG8_SA(b, h) (((b) * 2 + (h)) * HTB)
#define PG8_SB(b, h) ((4 + (b) * 2 + (h)) * HTB)
#define PG8_STAGE(bufoff, gbase, voff) do { _Pragma("unroll") for (int _i = 0; _i < 2; ++_i) \
        __builtin_amdgcn_global_load_lds((const unsigned*)((const char*)(gbase) + (voff)[_i]), (PG8_LAS unsigned*)(lds + (bufoff) + ldsw + _i * 8192), 16, 0, 0); } while (0)
#define PG8_LDA(dst, b, h) do { _Pragma("unroll") for (int m = 0; m < 4; ++m) _Pragma("unroll") for (int k = 0; k < 2; ++k) dst[m][k] = *(const PG8_LAS bf16x8*)(lds + PG8_SA(b, h) + aoff + m * 2048 + k * 1024); } while (0)
#define PG8_LDB(dst, b, h) do { _Pragma("unroll") for (int n = 0; n < 2; ++n) _Pragma("unroll") for (int k = 0; k < 2; ++k) dst[n][k] = *(const PG8_LAS bf16x8*)(lds + PG8_SB(b, h) + boff + n * 2048 + k * 1024); } while (0)
#define PG8_MMA(ai, bj, At, Bt) do { __builtin_amdgcn_s_setprio(1); _Pragma("unroll") for (int m = 0; m < 4; ++m) _Pragma("unroll") for (int n = 0; n < 2; ++n) _Pragma("unroll") for (int k = 0; k < 2; ++k) \
        acc[ai][bj][m][n] = __builtin_amdgcn_mfma_f32_16x16x32_bf16(Bt[n][k], At[m][k], acc[ai][bj][m][n], 0, 0, 0); __builtin_amdgcn_s_setprio(0); } while (0)
#define PG8_WAIT_V(n) asm volatile("s_waitcnt vmcnt(" #n ")" ::: "memory")
#define PG8_WAIT_L(n) asm volatile("s_waitcnt lgkmcnt(" #n ")" ::: "memory")
#define PG8_BAR __builtin_amdgcn_s_barrier()
#define PG8_SCHED __builtin_amdgcn_sched_barrier(0)
    Unit cur, nxt; int ui = 0;
    if (!S.next(0, cur)) return;
    f32x4 acc[2][2][4][2];
#pragma unroll
    for (int a = 0; a < 2; ++a)
#pragma unroll
        for (int b = 0; b < 2; ++b)
#pragma unroll
            for (int m = 0; m < 4; ++m)
#pragma unroll
                for (int n = 0; n < 2; ++n) acc[a][b][m][n] = (f32x4){0.f, 0.f, 0.f, 0.f};
    bf16x8 At[4][2], B0[2][2], B1[2][2];
    const char* cA = (const char*)g.A + (size_t)cur.pm * tstep; const char* cB = (const char*)g.Bt + (size_t)cur.pn * tstep;
    S.a_ready(cur);
    if constexpr (SP2) {
        PG8_STAGE(PG8_SB(0, 0), cB, voffB); PG8_STAGE(PG8_SB(0, 1), cB + hstep, voffB); PG8_STAGE(PG8_SA(0, 0), cA, voffA); PG8_STAGE(PG8_SA(0, 1), cA + hstep, voffA);
        if (wr == 1) PG8_BAR;
        PG8_WAIT_V(2); PG8_BAR;
        PG8_STAGE(PG8_SB(1, 0), cB + kstep, voffB); PG8_STAGE(PG8_SA(1, 0), cA + kstep, voffA); PG8_STAGE(PG8_SB(1, 1), cB + hstep + kstep, voffB);
        PG8_WAIT_V(6); PG8_BAR;
    } else {
        PG8_STAGE(PG8_SB(0, 0), cB, voffB); PG8_STAGE(PG8_SA(0, 0), cA, voffA); PG8_STAGE(PG8_SB(0, 1), cB + hstep, voffB); PG8_STAGE(PG8_SA(0, 1), cA + hstep, voffA);
        if (wr == 1) PG8_BAR;
        PG8_WAIT_V(4); PG8_BAR;
        PG8_STAGE(PG8_SB(1, 0), cB + kstep, voffB); PG8_STAGE(PG8_SA(1, 0), cA + kstep, voffA); PG8_STAGE(PG8_SB(1, 1), cB + hstep + kstep, voffB);
        PG8_WAIT_V(6); PG8_BAR;
    }
    for (;;) {
        const bool has_next = S.next(ui + 1, nxt);
        const char* nA = has_next ? (const char*)g.A + (size_t)nxt.pm * tstep : cA; const char* nB = has_next ? (const char*)g.Bt + (size_t)nxt.pn * tstep : cB;
        for (int t = 0; t < nt; t += 2) {
            const bool last = (t == nt - 2);
            const char* a1 = cA + (size_t)(t + 1) * kstep;
            const char* a2 = last ? nA : cA + (size_t)(t + 2) * kstep; const char* b2 = last ? nB : cB + (size_t)(t + 2) * kstep;
            const char* a3 = a2 + kstep; const char* b3 = b2 + kstep;
            if (last && has_next) S.a_ready(nxt);
            if constexpr (SP2) {
            PG8_LDB(B0, 0, 0); PG8_LDB(B1, 0, 1); PG8_SCHED; PG8_LDA(At, 0, 0); PG8_STAGE(PG8_SA(1, 1), a1 + hstep, voffA);
            PG8_WAIT_V(8); PG8_WAIT_L(0); PG8_BAR; PG8_MMA(0, 0, At, B0); PG8_MMA(0, 1, At, B1); PG8_BAR; PG8_SCHED;
            PG8_LDA(At, 0, 1); PG8_STAGE(PG8_SB(0, 0), b2, voffB); PG8_STAGE(PG8_SB(0, 1), b2 + hstep, voffB); PG8_STAGE(PG8_SA(0, 0), a2, voffA);
            PG8_WAIT_V(8); PG8_WAIT_L(0); PG8_BAR; PG8_MMA(1, 0, At, B0); PG8_MMA(1, 1, At, B1); PG8_BAR; PG8_SCHED;
            PG8_LDB(B0, 1, 0); PG8_LDB(B1, 1, 1); PG8_SCHED; PG8_LDA(At, 1, 0); PG8_STAGE(PG8_SA(0, 1), a2 + hstep, voffA);
            PG8_WAIT_V(8); PG8_WAIT_L(0); PG8_BAR; PG8_MMA(0, 0, At, B0); PG8_MMA(0, 1, At, B1); PG8_BAR; PG8_SCHED;
            PG8_LDA(At, 1, 1); PG8_STAGE(PG8_SB(1, 0), b3, voffB); PG8_STAGE(PG8_SB(1, 1), b3 + hstep, voffB); PG8_STAGE(PG8_SA(1, 0), a3, voffA);
            PG8_WAIT_V(8); PG8_WAIT_L(0); PG8_BAR; PG8_MMA(1, 0, At, B0); PG8_MMA(1, 1, At, B1); PG8_BAR; PG8_SCHED;
            } else {
            PG8_LDB(B0, 0, 0); PG8_SCHED; PG8_LDA(At, 0, 0); PG8_STAGE(PG8_SA(1, 1), a1 + hstep, voffA);
            PG8_WAIT_L(8); PG8_BAR; PG8_WAIT_L(0); PG8_MMA(0, 0, At, B0); PG8_BAR; PG8_SCHED;
            PG8_LDB(B1, 0, 1); PG8_STAGE(PG8_SB(0, 0), b2, voffB);
            PG8_BAR; PG8_WAIT_L(0); PG8_MMA(0, 1, At, B1); PG8_BAR;
            PG8_LDA(At, 0, 1); PG8_STAGE(PG8_SA(0, 0), a2, voffA);
            PG8_BAR; PG8_WAIT_L(0); PG8_MMA(1, 0, At, B0); PG8_BAR; PG8_SCHED;
            PG8_STAGE(PG8_SB(0, 1), b2 + hstep, voffB);
            PG8_WAIT_V(6); PG8_BAR; PG8_MMA(1, 1, At, B1); PG8_BAR;
            PG8_LDB(B0, 1, 0); PG8_SCHED; PG8_LDA(At, 1, 0); PG8_STAGE(PG8_SA(0, 1), a2 + hstep, voffA);
            PG8_WAIT_L(8); PG8_BAR; PG8_WAIT_L(0); PG8_MMA(0, 0, At, B0); PG8_BAR; PG8_SCHED;
            PG8_LDB(B1, 1, 1); PG8_STAGE(PG8_SB(1, 0), b3, voffB);
            PG8_BAR; PG8_WAIT_L(0); PG8_MMA(0, 1, At, B1); PG8_BAR;
            PG8_LDA(At, 1, 1); PG8_STAGE(PG8_SA(1, 0), a3, voffA);
            PG8_BAR; PG8_WAIT_L(0); PG8_MMA(1, 0, At, B0); PG8_BAR; PG8_SCHED;
            PG8_STAGE(PG8_SB(1, 1), b3 + hstep, voffB);
            PG8_WAIT_V(6); PG8_BAR; PG8_MMA(1, 1, At, B1); PG8_BAR;
            }
        }
        if constexpr (ALIGN_EPI) { if (wr == 0) PG8_BAR; }
        if constexpr (!Epi::AFTER_DRAIN) { E(acc, cur, wr, wc, fr, fq); S.done(cur); }
        if (!has_next) break;
#pragma unroll
        for (int a = 0; a < 2; ++a)
#pragma unroll
            for (int b = 0; b < 2; ++b)
#pragma unroll
                for (int m = 0; m < 4; ++m)
#pragma unroll
                    for (int n = 0; n < 2; ++n) acc[a][b][m][n] = (f32x4){0.f, 0.f, 0.f, 0.f};
        cur = nxt; cA = nA; cB = nB; ++ui;
        if constexpr (ALIGN_EPI) { if (wr == 1) PG8_BAR; }
    }
    PG8_WAIT_V(0);
    if constexpr (!ALIGN_EPI) { if (wr == 0) PG8_BAR; }
    PG8_BAR;
    if constexpr (Epi::AFTER_DRAIN) { E.fused(acc, cur, wr, wc, fr, fq, lds, wid, lane); S.done(cur); }
#undef PG8_SA
#undef PG8_SB
#undef PG8_STAGE
#undef PG8_LDA
#undef PG8_LDB
#undef PG8_MMA
#undef PG8_WAIT_V
#undef PG8_WAIT_L
#undef PG8_BAR
#undef PG8_SCHED
}
}
#ifndef PG8_SP2
#define PG8_SP2 true
#endif
#ifndef PG8_ALIGN
#define PG8_ALIGN true
#endif
#ifndef MK_ONE_LAUNCH
#define MK_ONE_LAUNCH 1
#endif

constexpr int NWAVES = 8;
constexpr int T = 32768, D = 4096, TP = 16384, DFF = 16384, NIN = 9248, LDP = 9472, NB = 12, MODW = 6 * D;
constexpr int C_QA = 0, C_KA = 2048, C_VA = 2560, C_QG = 3072, C_KG = 4096, C_VG = 5120, C_RG = 7168, C_AF = 9216, C_AB = 9232;
constexpr int MLP_CH = 4, MLP_ROWS = T / MLP_CH;
constexpr int OFF_SH1 = 0, OFF_SC1 = D, OFF_G1 = 2 * D, OFF_SH2 = 3 * D, OFF_SC2 = 4 * D, OFF_G2 = 5 * D;
constexpr int N_PHASES = 16;

constexpr size_t MiB = 1u << 20;
constexpr size_t WS_CTL = 0, CTL_ZERO_BYTES = 1 * MiB;
constexpr size_t WS_MOD = 1 * MiB;
constexpr size_t WS_WIN = 4 * MiB;
constexpr size_t WS_WOUT = 78 * MiB;
constexpr size_t WS_H = 110 * MiB;
constexpr size_t WS_PROJ = 366 * MiB;
constexpr size_t WS_MIX = 958 * MiB;
constexpr size_t WS_OF = 1214 * MiB, WS_OB = 1342 * MiB;
constexpr size_t WS_END = 1470 * MiB;
constexpr size_t WS_WMI = 110 * MiB, WS_WMO = 238 * MiB;
constexpr size_t WS_H2 = 366 * MiB;
constexpr size_t WS_HID0 = 622 * MiB, WS_HID1 = 878 * MiB;
static_assert(WS_HID1 + (size_t)MLP_ROWS * DFF * 2 <= WS_END && WS_WIN + (size_t)LDP * D * 2 <= WS_WOUT && WS_PROJ + (size_t)T * LDP * 2 <= WS_MIX, "ws map");
constexpr int CW_TMO = 0, CW_BAR = 4096, CW_QUEUE = 16384;

constexpr int RING_OFF = 0, RING_BYTES = 131072;
constexpr int LDS_BYTES = 147456;
constexpr int LDSCTL_OFF = LDS_BYTES - 1024, MISC_OFF = LDSCTL_OFF + 320;

#define GAS __attribute__((address_space(1)))
#define LAS __attribute__((address_space(3)))
#define DI __device__ __forceinline__
typedef unsigned short bf16;
typedef unsigned v4u __attribute__((ext_vector_type(4)));
typedef unsigned v2u __attribute__((ext_vector_type(2)));
typedef float f32x4 __attribute__((ext_vector_type(4)));
typedef float f32x2 __attribute__((ext_vector_type(2)));
typedef float f32x16 __attribute__((ext_vector_type(16)));
typedef short bf16x8 __attribute__((ext_vector_type(8)));
typedef short s16x4 __attribute__((ext_vector_type(4)));
typedef GAS unsigned gu32;
#define RLX_AGENT __ATOMIC_RELAXED, __HIP_MEMORY_SCOPE_AGENT
#define LDS_WAIT() asm volatile("s_waitcnt lgkmcnt(0)" ::: "memory")
#define MFMA32(a, b, c) __builtin_amdgcn_mfma_f32_32x32x16_bf16((a), (b), (c), 0, 0, 0)
DI unsigned pk2(float lo, float hi) { return pg8::cvt_pk_bf16(lo, hi); }
DI float bf_lo(unsigned u) { return __builtin_bit_cast(float, u << 16); }
DI float bf_hi(unsigned u) { return __builtin_bit_cast(float, u & 0xffff0000u); }

#define XB_TMO      128
#define XB_XCNT(j)  (256  + 64 * (j))
#define XB_XSUB(j)  (1280 + 64 * (j))
#define XB_XGEN(j)  (2304 + 64 * (j))
#define XB_TOP      3328
#define XB_TOPGEN   3392
#define XCD_BAR_WORDS 3456
#define XB_SPIN_CAP (1u << 20)

DI unsigned xb_ld(unsigned* p)              { return __hip_atomic_load(p, __ATOMIC_RELAXED, __HIP_MEMORY_SCOPE_AGENT); }
DI unsigned xb_add(unsigned* p, unsigned v) { return __hip_atomic_fetch_add(p, v, __ATOMIC_RELAXED, __HIP_MEMORY_SCOPE_AGENT); }
DI unsigned xb_xcc_id() { return (unsigned)__builtin_amdgcn_s_getreg((3 << 11) | 20) & 0xFu; }
#define XB_SPIN(cond, bar) do { unsigned _sp = 0; while (cond) { __builtin_amdgcn_s_sleep(1); \
    if ((++_sp & 255u) == 0u) { if (xb_ld(&(bar)[XB_TMO])) break; if (_sp > XB_SPIN_CAP) { atomicAdd(&(bar)[XB_TMO], 1u); break; } } } } while (0)

struct XcdBarrier { unsigned* bar; unsigned x; volatile LAS unsigned* st; };
DI XcdBarrier xcd_barrier_post(unsigned* bar, volatile LAS unsigned* st) {
    XcdBarrier b; b.bar = bar; b.x = xb_xcc_id(); b.st = st;
    if (threadIdx.x == 0) (void)xb_add(&bar[XB_XCNT(b.x)], 1u);
    return b;
}
DI void xcd_barrier_complete(unsigned* bar, unsigned x, unsigned& nloc, unsigned& nx) {
    const unsigned G = gridDim.x * gridDim.y * gridDim.z;
    unsigned sum, cnt, mine, sp = 0u;
    for (;;) {
        sum = 0u; cnt = 0u; mine = 0u;
#pragma unroll
        for (unsigned j = 0; j < 16; ++j) { const unsigned c = xb_ld(&bar[XB_XCNT(j)]); sum += c; cnt += (c > 0u) ? 1u : 0u; mine = (j == x) ? c : mine; }
        if (sum == G) break;
        __builtin_amdgcn_s_sleep(1);
        if ((++sp & 255u) == 0u) { if (xb_ld(&bar[XB_TMO])) break; if (sp > XB_SPIN_CAP) { atomicAdd(&bar[XB_TMO], 1u); break; } }
    }
    nloc = mine > 0u ? mine : 1u; nx = cnt > 0u ? cnt : 1u;
}
DI void xcd_barrier(const XcdBarrier& b) {
    asm volatile("s_waitcnt vmcnt(0)" ::: "memory");
    __syncthreads();
    if (threadIdx.x == 0) {
        unsigned* bar = b.bar;
        __builtin_amdgcn_s_waitcnt(0);
        unsigned nloc = b.st[0], nx = b.st[1];
        if (nloc == 0u) { xcd_barrier_complete(bar, b.x, nloc, nx); b.st[0] = nloc; b.st[1] = nx; }
        const unsigned old = xb_add(&bar[XB_XSUB(b.x)], 1u);
        const unsigned gen = old / nloc;
        if (old + 1u == (gen + 1u) * nloc) {
            __builtin_amdgcn_fence(__ATOMIC_RELEASE, "agent");
            asm volatile("s_waitcnt vmcnt(0)" ::: "memory");
            const unsigned og = xb_add(&bar[XB_TOP], 1u);
            const unsigned tg = og / nx;
            if (og + 1u == (tg + 1u) * nx) xb_add(&bar[XB_TOPGEN], 1u);
            else XB_SPIN(xb_ld(&bar[XB_TOPGEN]) == tg, bar);
            __builtin_amdgcn_fence(__ATOMIC_ACQUIRE, "agent");
            xb_add(&bar[XB_XGEN(b.x)], 1u);
            asm volatile("s_waitcnt vmcnt(0)" ::: "memory");
        } else {
            XB_SPIN(xb_ld(&bar[XB_XGEN(b.x)]) == gen, bar);
            __builtin_amdgcn_fence(__ATOMIC_ACQUIRE, "agent");
            asm volatile("s_waitcnt vmcnt(0)" ::: "memory");
        }
    }
    __syncthreads();
}

struct Frame {
    LAS unsigned char* lds;
    volatile LAS unsigned* MISC;
    gu32* ctl;
    int tid, lane, wave;
    int vcu, G;
    const float *xp, *xs, *cp, *cs, *w_ada, *b_ada, *norm1_g, *w_in, *wa_f, *ba_f, *wa_b, *ba_b, *gla_norm_g, *sink, *rel_bias, *w_out, *norm2_g, *w_mi, *w_mo, *final_g;
    float* out; float* mod;
    bf16 *Win_t, *Wout_t, *Wmi_t, *Wmo_t, *H, *H2, *PROJ, *MIX, *OF, *OB, *HID0, *HID1;
};
DI int seq_of_row(int r) { return r < TP ? (r >> 11) : 8 + ((r - TP) >> 12); }
DI int seq_base(int s) { return s < 8 ? s * 2048 : TP + (s - 8) * 4096; }
DI int seq_len(int s) { return s < 8 ? 2048 : 4096; }
DI float wave_sum(float v) {
#pragma unroll
    for (int o = 1; o < 64; o <<= 1) v += __shfl_xor(v, o);
    return v;
}

DI void p0_mod(Frame& F) {
    LAS float* sb = (LAS float*)(F.lds + F.wave * 3072);
    LAS float* red = (LAS float*)(F.lds + 32768);
    for (int slab = F.vcu; slab < MODW / 96; slab += F.G) {
        const int col0 = slab * 96 + 2 * F.lane;
        f32x2 acc[NB];
#pragma unroll
        for (int j = 0; j < NB; ++j) acc[j] = (f32x2){0.f, 0.f};
        for (int kc = 0; kc < 8; ++kc) {
            const int k0 = F.wave * 512 + kc * 64;
#pragma unroll
            for (int j = 0; j < NB; ++j) { const float c = (j < 8) ? F.cp[j * D + k0 + F.lane] : F.cs[(j - 8) * D + k0 + F.lane];
                sb[F.lane * NB + j] = c / (1.f + __expf(-c)); }
            LDS_WAIT();
            if (F.lane < 48) {
#pragma unroll 16
                for (int kk = 0; kk < 64; ++kk) {
                    const f32x2 w = *(const f32x2*)(F.w_ada + (size_t)(k0 + kk) * MODW + col0);
                    const f32x4 s0 = *(const LAS f32x4*)(sb + kk * NB), s1 = *(const LAS f32x4*)(sb + kk * NB + 4), s2 = *(const LAS f32x4*)(sb + kk * NB + 8);
                    acc[0] += s0[0] * w; acc[1] += s0[1] * w; acc[2] += s0[2] * w; acc[3] += s0[3] * w;
                    acc[4] += s1[0] * w; acc[5] += s1[1] * w; acc[6] += s1[2] * w; acc[7] += s1[3] * w;
                    acc[8] += s2[0] * w; acc[9] += s2[1] * w; acc[10] += s2[2] * w; acc[11] += s2[3] * w;
                }
            }
            LDS_WAIT();
        }
        if (F.lane < 48) {
#pragma unroll
            for (int j = 0; j < NB; ++j) *(LAS f32x2*)(red + (F.wave * NB + j) * 96 + 2 * F.lane) = acc[j];
        }
        __syncthreads();
        for (int o = F.tid; o < NB * 96; o += NWAVES * 64) { const int j = o / 96, cc = o % 96; float s = F.b_ada[slab * 96 + cc];
#pragma unroll
            for (int w = 0; w < NWAVES; ++w) s += red[(w * NB + j) * 96 + cc];
            F.mod[j * MODW + slab * 96 + cc] = s; }
        __syncthreads();
    }
}
DI void transpose_item(const float* W, int K, int N, bf16* WT, LAS float* scr, int item, int lane) {
    const int nblk = N / 32, kb = item / nblk, nb = item % nblk, k0 = 64 * kb, n0 = 32 * nb;
#pragma unroll 8
    for (int i = 0; i < 32; ++i) { const int kk = 2 * i + (lane >> 5); scr[kk * 33 + (lane & 31)] = W[(size_t)(k0 + kk) * N + n0 + (lane & 31)]; }
    LDS_WAIT(); asm volatile("" ::: "memory");
    const int c = lane & 7;
#pragma unroll
    for (int j = 0; j < 4; ++j) { const int n = (lane >> 3) + 8 * j; const LAS float* s = scr + (8 * c) * 33 + n;
        v4u o; o.x = pk2(s[0 * 33], s[1 * 33]); o.y = pk2(s[2 * 33], s[3 * 33]); o.z = pk2(s[4 * 33], s[5 * 33]); o.w = pk2(s[6 * 33], s[7 * 33]);
        *(GAS v4u*)(WT + (size_t)(n0 + n) * K + k0 + 8 * c) = o; }
    LDS_WAIT(); asm volatile("" ::: "memory");
}
DI void p0_prologue(Frame& F) {
    p0_mod(F);
    LAS float* scr = (LAS float*)(F.lds + F.wave * 8704);
    const int gw = F.vcu * NWAVES + F.wave, NGW = F.G * NWAVES;
    constexpr int I_IN = (D / 64) * (NIN / 32), I_OUT = (D / 64) * (D / 32);
    for (int it = gw; it < I_IN + I_OUT; it += NGW) {
        if (it < I_IN) transpose_item(F.w_in, D, NIN, F.Win_t, scr, it, F.lane);
        else transpose_item(F.w_out, D, D, F.Wout_t, scr, it - I_IN, F.lane);
    }
    { GAS v4u* z = (GAS v4u*)(F.Win_t + (size_t)NIN * D); const int nz = (LDP - NIN) * D * 2 / 16;
      for (int i = (F.vcu * NWAVES * 64) + F.tid; i < nz; i += F.G * NWAVES * 64) z[i] = (v4u){0u, 0u, 0u, 0u}; }
}
constexpr int CONV_ITEMS = (D / 64) * (DFF / 32) + (DFF / 64) * (D / 32), CONV_GRAN = 32, N_CONV_GRAN = CONV_ITEMS / CONV_GRAN;
DI void conv_granule(Frame& F, int g) {
    LAS float* scr = (LAS float*)(F.lds + F.wave * 8704);
    constexpr int I_MI = (D / 64) * (DFF / 32);
#pragma unroll 1
    for (int j = 0; j < CONV_GRAN / NWAVES; ++j) { const int it = g * CONV_GRAN + j * NWAVES + F.wave;
        if (it < I_MI) transpose_item(F.w_mi, D, DFF, F.Wmi_t, scr, it, F.lane);
        else transpose_item(F.w_mo, DFF, D, F.Wmo_t, scr, it - I_MI, F.lane); }
}

template <int MODE> DI void norm_phase(Frame& F) {
    LAS float* P = (LAS float*)F.lds; LAS float* Q = P + D;
    const float* gvec = MODE == 0 ? F.norm1_g : (MODE == 1 ? F.norm2_g : F.final_g);
    constexpr int SC = MODE == 0 ? OFF_SC1 : OFF_SC2, SH = MODE == 0 ? OFF_SH1 : OFF_SH2;
    for (int rc = F.vcu; rc < T / 128; rc += F.G) {
        const int r0 = rc * 128, b = seq_of_row(r0);
        __syncthreads();
        for (int c4 = F.tid; c4 < D / 4; c4 += NWAVES * 64) {
            const f32x4 g = *(const f32x4*)(gvec + 4 * c4);
            if (MODE < 2) { const f32x4 sc = *(const f32x4*)(F.mod + b * MODW + SC + 4 * c4), sh = *(const f32x4*)(F.mod + b * MODW + SH + 4 * c4);
                *(LAS f32x4*)(P + 4 * c4) = g * (1.f + sc); *(LAS f32x4*)(Q + 4 * c4) = sh; }
            else *(LAS f32x4*)(P + 4 * c4) = g;
        }
        __syncthreads();
        for (int rr = F.wave; rr < 128; rr += NWAVES) {
            const int row = r0 + rr;
            const float* src = MODE == 0 ? (row < TP ? F.xp + (size_t)row * D : F.xs + (size_t)(row - TP) * D) : F.out + (size_t)row * D;
            f32x4 v[16]; float ss = 0.f;
#pragma unroll
            for (int j = 0; j < 16; ++j) { v[j] = *(const f32x4*)(src + 4 * (F.lane + 64 * j)); ss += (v[j][0] * v[j][0] + v[j][1] * v[j][1]) + (v[j][2] * v[j][2] + v[j][3] * v[j][3]); }
            const float rstd = 1.f / sqrtf(wave_sum(ss) * (1.f / D) + 1e-6f);
#pragma unroll
            for (int j = 0; j < 16; ++j) {
                const int c = 4 * (F.lane + 64 * j);
                const f32x4 p = *(const LAS f32x4*)(P + c);
                if (MODE < 2) { const f32x4 q = *(const LAS f32x4*)(Q + c); const f32x4 y = v[j] * rstd * p + q;
                    v2u w; w.x = pk2(y[0], y[1]); w.y = pk2(y[2], y[3]); *(GAS v2u*)((MODE == 0 ? F.H : F.H2) + (size_t)row * D + c) = w; }
                else *(f32x4*)(F.out + (size_t)row * D + c) = v[j] * rstd * p;
            }
        }
    }
}

DI unsigned off_b(unsigned row, unsigned ch) { return 256u * row + 16u * (ch ^ (((row & 3u) << 2) | ((row >> 2) & 3u))); }
DI s16x4 tr_read(LAS unsigned char* p) { return __builtin_amdgcn_ds_read_tr16_b64_v4i16((LAS s16x4*)p); }
DI bf16x8 cat8(s16x4 a, s16x4 b) { return __builtin_shufflevector(a, b, 0, 1, 2, 3, 4, 5, 6, 7); }
template <int S> DI bf16x8 pack8(const f32x16& x) {
    v4u p; p.x = pk2(x[8 * S + 0], x[8 * S + 1]); p.y = pk2(x[8 * S + 2], x[8 * S + 3]); p.z = pk2(x[8 * S + 4], x[8 * S + 5]); p.w = pk2(x[8 * S + 6], x[8 * S + 7]);
    return __builtin_bit_cast(bf16x8, p);
}
DI int t5_bucket(int rel) {
    const int n = rel < 0 ? -rel : rel; int v;
    if (n < 8) v = n; else if (n < 12) v = 8; else if (n < 16) v = 9; else if (n < 23) v = 10; else if (n < 32) v = 11; else if (n < 46) v = 12; else if (n < 64) v = 13; else if (n < 91) v = 14; else v = 15;
    return (rel > 0 ? 16 : 0) + v;
}
constexpr int ATT_BT_OFF = 65536;
constexpr float LOG2E = 1.4426950408889634f;
constexpr float ATT_SCL = 0.08838834764831845f * 1.4426950408889634f;

DI void attn_item(Frame& F, int item) {
    LAS unsigned char* lds = F.lds;
    const LAS float* btab = (const LAS float*)(F.lds + ATT_BT_OFF);
    const int kvh = item & 3, sq = item >> 2;
    int seq, qh; if (sq < 256) { seq = sq >> 5; qh = sq & 31; } else { seq = 8 + ((sq - 256) >> 6); qh = (sq - 256) & 63; }
    const int S_len = seq_len(seq), base = seq_base(seq);
    const int head = 4 * kvh + (F.wave >> 1), r_ = F.lane & 31, hh_ = F.lane >> 5;
    const int r = r_, hh = hh_;
    const int qpos = 64 * qh + 32 * (F.wave & 1) + r, qrow = base + qpos;
    bf16x8 qf[8];
    { const bf16* qp = F.PROJ + (size_t)qrow * LDP + C_QA + head * 128 + 8 * hh;
#pragma unroll
      for (int ks = 0; ks < 8; ++ks) qf[ks] = *(const bf16x8*)(qp + 16 * ks); }
    const int tlo = qh >= 2 ? 0 : 2 - qh; int thi = S_len / 64 - qh + 1; if (thi > 4) thi = 4;
    float m = F.sink[head] * LOG2E, l = hh == 0 ? 1.f : 0.f;
    f32x16 o[4];
#pragma unroll
    for (int c = 0; c < 4; ++c)
#pragma unroll
        for (int i = 0; i < 16; ++i) o[c][i] = 0.f;
    v4u kreg[2], vreg[2];
    const int srow = F.tid >> 4, sch = F.tid & 15;
    const bf16* kvp = F.PROJ + (ptrdiff_t)(base + 64 * qh - 128 + srow) * LDP + kvh * 128 + sch * 8;
#define ATT_PREFETCH(t) do { _Pragma("unroll") for (int i_ = 0; i_ < 2; ++i_) { const bf16* p_ = kvp + (ptrdiff_t)(64 * (t) + 32 * i_) * LDP; \
        kreg[i_] = *(const GAS v4u*)(p_ + C_KA); vreg[i_] = *(const GAS v4u*)(p_ + C_VA); } } while (0)
    ATT_PREFETCH(tlo);
    for (int t = tlo; t <= thi; ++t) {
        const int buf = (t - tlo) & 1;
        unsigned r = r_, hh = hh_, q4 = (F.lane & 15) >> 2, p4 = F.lane & 3, blk = (F.lane >> 4) & 1;
        asm volatile("" : "+v"(r), "+v"(hh), "+v"(q4), "+v"(p4), "+v"(blk));
        LAS unsigned char* Kb = lds + buf * 16384; LAS unsigned char* Vb = lds + 32768 + buf * 16384;
#pragma unroll
        for (int i = 0; i < 2; ++i) { const unsigned a = off_b(srow + 32 * i, sch); *(LAS v4u*)(Kb + a) = kreg[i]; *(LAS v4u*)(Vb + a) = vreg[i]; }
        if (t < thi) ATT_PREFETCH(t + 1);
        __syncthreads();
        const int key0 = 64 * qh - 128 + 64 * t;
        f32x16 st[2];
#pragma unroll
        for (int kt = 0; kt < 2; ++kt) {
#pragma unroll
            for (int i = 0; i < 16; ++i) st[kt][i] = 0.f;
#pragma unroll
            for (int ks = 0; ks < 8; ++ks) { const bf16x8 ka = *(const LAS bf16x8*)(Kb + 8192 * kt + off_b(r, 2 * ks + hh)); st[kt] = MFMA32(ka, qf[ks], st[kt]); }
        }
        const LAS float* bt = btab + head * 384 + (key0 - qpos + 4 * hh + 192);
        float mx = -3.0e38f;
#pragma unroll
        for (int kt = 0; kt < 2; ++kt)
#pragma unroll
            for (int i = 0; i < 16; ++i) { const float tv = st[kt][i] * ATT_SCL + bt[32 * kt + (i & 3) + 8 * (i >> 2)]; st[kt][i] = tv; mx = fmaxf(mx, tv); }
        mx = fmaxf(mx, __shfl_xor(mx, 32));
        const float mn = fmaxf(m, mx), alpha = __builtin_amdgcn_exp2f(m - mn); m = mn;
        float ls = 0.f;
#pragma unroll
        for (int kt = 0; kt < 2; ++kt)
#pragma unroll
            for (int i = 0; i < 16; ++i) { const float p = __builtin_amdgcn_exp2f(st[kt][i] - mn); st[kt][i] = p; ls += p; }
        l = l * alpha + ls;
#pragma unroll
        for (int c = 0; c < 4; ++c)
#pragma unroll
            for (int i = 0; i < 16; ++i) o[c][i] *= alpha;
#pragma unroll
        for (int s = 0; s < 4; ++s) {
            const bf16x8 pb = (s & 1) ? pack8<1>(st[s >> 1]) : pack8<0>(st[s >> 1]);
#pragma unroll
            for (int c = 0; c < 4; ++c) {
                const unsigned a0 = off_b(16 * s + 4 * hh + q4, 4 * c + 2 * blk + (p4 >> 1)) + 8 * (p4 & 1);
                const unsigned a1 = off_b(16 * s + 8 + 4 * hh + q4, 4 * c + 2 * blk + (p4 >> 1)) + 8 * (p4 & 1);
                const bf16x8 va = cat8(tr_read(Vb + a0), tr_read(Vb + a1));
                o[c] = MFMA32(va, pb, o[c]);
            }
        }
    }
#undef ATT_PREFETCH
    l += __shfl_xor(l, 32);
    const float inv = 1.f / l;
    __syncthreads();
    {
        LAS unsigned char* ost = lds + F.wave * 8192;
#pragma unroll
        for (int c = 0; c < 4; ++c)
#pragma unroll
            for (int g = 0; g < 4; ++g) { v2u w; w.x = pk2(o[c][4 * g] * inv, o[c][4 * g + 1] * inv); w.y = pk2(o[c][4 * g + 2] * inv, o[c][4 * g + 3] * inv);
                const unsigned d = 32 * c + 8 * g + 4 * hh;
                *(LAS v2u*)(ost + r * 256 + (((d >> 3) ^ (r & 15)) << 4) + ((d & 7) << 1)) = w; }
        bf16* ob = F.MIX + (size_t)(base + 64 * qh + 32 * (F.wave & 1)) * D + head * 128;
#pragma unroll
        for (int i = 0; i < 8; ++i) { const int q = F.lane + 64 * i, row = q >> 4, ch = q & 15;
            const v4u w = *(const LAS v4u*)(ost + row * 256 + ((ch ^ (row & 15)) << 4));
            *(GAS v4u*)(ob + (size_t)row * D + ch * 8) = w; }
    }
    __syncthreads();
}

constexpr int GL_OPS = 0, GL_V = 49152, GL_AT = 98304, GL_TOT = 106496, GL_DEC = 114688, GL_WA = 115712, GL_OST = 123904;
static_assert(GL_OST + 8 * 2048 <= LDSCTL_OFF, "GLA LDS map");
struct GlaCtx { const bf16* proj; bf16* obuf; int base, S_len, nchunk, hd, dir, acol; f32x2 bav; };
DI void gla_load_qk(const Frame& F, const GlaCtx& C, unsigned (&qv)[4], unsigned (&kv)[4], int n) {
    const int p0 = C.dir ? C.S_len - 32 * (n + 1) : 32 * n;
#pragma unroll
    for (int i = 0; i < 4; ++i) { const int c = 4 * F.wave + i, orow = C.dir ? 31 - c : c;
        const bf16* p = C.proj + (size_t)(C.base + p0 + orow) * LDP + C.hd * 128 + 2 * F.lane; qv[i] = *(const GAS unsigned*)(p + C_QG); kv[i] = *(const GAS unsigned*)(p + C_KG); }
}
DI void gla_load_v(const Frame& F, const GlaCtx& C, v4u (&vv)[2], int n) {
    const int p0 = C.dir ? C.S_len - 32 * (n + 1) : 32 * n;
    const int vrow = F.tid >> 5, vch = F.tid & 31;
#pragma unroll
    for (int i = 0; i < 2; ++i) vv[i] = *(const GAS v4u*)(C.proj + (size_t)(C.base + p0 + vrow + 16 * i) * LDP + C_VG + C.hd * 256 + vch * 8);
}
DI void gla_load_a(const Frame& F, const GlaCtx& C, v4u& av, int n) {
    const int p0 = C.dir ? C.S_len - 32 * (n + 1) : 32 * n;
    if (F.tid < 64) av = *(const GAS v4u*)(C.proj + (size_t)(C.base + p0 + (F.tid >> 1)) * LDP + C.acol + (F.tid & 1) * 8);
}
DI void gla_b2(const Frame& F, const GlaCtx& C, const f32x2 (&cum)[4], const unsigned (&qv)[4], const unsigned (&kv)[4], int m) {
    LAS unsigned char* lds = F.lds; const int lane = F.lane, wave = F.wave;
    LAS unsigned char* ops = lds + GL_OPS + (m & 1) * 24576;
    const LAS float* totp = (const LAS float*)(lds + GL_TOT + (m & 1) * 4096);
    f32x2 pre = (f32x2){0.f, 0.f}, tot = (f32x2){0.f, 0.f};
#pragma unroll
    for (int w = 0; w < 8; ++w) { const f32x2 tw = *(const LAS f32x2*)(totp + w * 128 + 2 * lane); if (w < wave) pre += tw; tot += tw; }
#pragma unroll
    for (int i = 0; i < 4; ++i) {
        const int c = 4 * wave + i; const f32x2 b = pre + cum[i];
        const float eb0 = __expf(b[0]), eb1 = __expf(b[1]), en0 = __expf(-b[0]), en1 = __expf(-b[1]), ed0 = __expf(tot[0] - b[0]), ed1 = __expf(tot[1] - b[1]);
        const float q0 = bf_lo(qv[i]) * 0.08838834764831845f, q1 = bf_hi(qv[i]) * 0.08838834764831845f, k0 = bf_lo(kv[i]), k1 = bf_hi(kv[i]);
        const unsigned a = off_b(c, lane >> 2) + 4 * (lane & 3);
        *(LAS unsigned*)(ops + a) = pk2(q0 * eb0, q1 * eb1);
        *(LAS unsigned*)(ops + 8192 + a) = pk2(k0 * en0, k1 * en1);
        *(LAS unsigned*)(ops + 16384 + a) = pk2(k0 * ed0, k1 * ed1);
    }
    if (wave == 0) *(LAS f32x2*)((LAS float*)(lds + GL_DEC + (m & 1) * 512) + 2 * lane) = (f32x2){__expf(tot[0]), __expf(tot[1])};
}
DI void gla_b1(const Frame& F, const GlaCtx& C, f32x2 (&cum)[4], int m) {
    LAS unsigned char* lds = F.lds; const int lane = F.lane, wave = F.wave;
    const LAS float* atp = (const LAS float*)(lds + GL_AT + (m & 3) * 2048);
    f32x2 x[4] = {C.bav, C.bav, C.bav, C.bav};
#pragma unroll
    for (int j4 = 0; j4 < 4; ++j4) {
        f32x2 w[4];
#pragma unroll
        for (int j = 0; j < 4; ++j) w[j] = *(const LAS f32x2*)((const LAS float*)(lds + GL_WA) + (4 * j4 + j) * 128 + 2 * lane);
#pragma unroll
        for (int i = 0; i < 4; ++i) { const f32x4 a = *(const LAS f32x4*)(atp + (4 * wave + i) * 16 + 4 * j4);
            x[i] += a[0] * w[0] + a[1] * w[1] + a[2] * w[2] + a[3] * w[3]; }
    }
#pragma unroll
    for (int i = 0; i < 4; ++i) { f32x2 lg;
        lg[0] = (fminf(x[i][0], 0.f) - __logf(1.f + __expf(-fabsf(x[i][0])))) * 0.0625f;
        lg[1] = (fminf(x[i][1], 0.f) - __logf(1.f + __expf(-fabsf(x[i][1])))) * 0.0625f;
        cum[i] = i ? cum[i - 1] + lg : lg; }
    *(LAS f32x2*)((LAS float*)(lds + GL_TOT + (m & 1) * 4096) + wave * 128 + 2 * lane) = cum[3];
}
DI void gla_stage_v(const Frame& F, const GlaCtx& C, const v4u (&vv)[2], int vbuf) {
    LAS unsigned char* Vb = F.lds + GL_V + vbuf * 16384; const int vrow = F.tid >> 5, vch = F.tid & 31;
#pragma unroll
    for (int i = 0; i < 2; ++i) { const int srow = vrow + 16 * i, c = C.dir ? 31 - srow : srow; *(LAS v4u*)(Vb + (vch >> 4) * 8192 + off_b(c, vch & 15)) = vv[i]; }
}
DI void gla_stage_a(const Frame& F, const GlaCtx& C, const v4u& av, int m) {
    if (F.tid < 64) { const int srow = F.tid >> 1, c = C.dir ? 31 - srow : srow; LAS float* ap = (LAS float*)(F.lds + GL_AT + (m & 3) * 2048) + c * 16 + (F.tid & 1) * 8;
        *(LAS f32x4*)ap = (f32x4){bf_lo(av.x), bf_hi(av.x), bf_lo(av.y), bf_hi(av.y)}; *(LAS f32x4*)(ap + 4) = (f32x4){bf_lo(av.z), bf_hi(av.z), bf_lo(av.w), bf_hi(av.w)}; }
}
DI void gla_mfma(const Frame& F, const GlaCtx& C, f32x16 (&St)[4], int n, int vbuf) {
    LAS unsigned char* lds = F.lds; const int lane = F.lane, wave = F.wave, dir = C.dir;
    const int p0 = dir ? C.S_len - 32 * (n + 1) : 32 * n;
    LAS unsigned char* QT = lds + GL_OPS + (n & 1) * 24576; LAS unsigned char* KT = QT + 8192; LAS unsigned char* KD = QT + 16384;
    unsigned r = lane & 31, hh = lane >> 5, q4 = (lane & 15) >> 2, p4 = lane & 3, blk = (lane >> 4) & 1;
    asm volatile("" : "+v"(r), "+v"(hh), "+v"(q4), "+v"(p4), "+v"(blk));
    LAS unsigned char* Vi = lds + GL_V + vbuf * 16384 + (wave >> 2) * 8192; const unsigned cV = wave & 3;
    f32x16 at;
#pragma unroll
    for (int i = 0; i < 16; ++i) at[i] = 0.f;
#pragma unroll
    for (int ks = 0; ks < 8; ++ks) { const unsigned a = off_b(r, 2 * ks + hh);
        at = MFMA32(*(const LAS bf16x8*)(KT + a), *(const LAS bf16x8*)(QT + a), at); }
#pragma unroll
    for (int i = 0; i < 16; ++i) if ((unsigned)((i & 3) + 8 * (i >> 2)) + 4 * hh > r) at[i] = 0.f;
    f32x16 o;
#pragma unroll
    for (int i = 0; i < 16; ++i) o[i] = 0.f;
#pragma unroll
    for (int kt = 0; kt < 4; ++kt) {
        { const bf16x8 qa = cat8(*(const LAS s16x4*)(QT + off_b(r, 4 * kt + 0) + 8 * hh), *(const LAS s16x4*)(QT + off_b(r, 4 * kt + 1) + 8 * hh));
          o = MFMA32(qa, pack8<0>(St[kt]), o); }
        { const bf16x8 qa = cat8(*(const LAS s16x4*)(QT + off_b(r, 4 * kt + 2) + 8 * hh), *(const LAS s16x4*)(QT + off_b(r, 4 * kt + 3) + 8 * hh));
          o = MFMA32(qa, pack8<1>(St[kt]), o); }
    }
    {
        const unsigned cc = 4 * cV + 2 * blk + (p4 >> 1), po = 8 * (p4 & 1);
        const bf16x8 v0 = cat8(tr_read(Vi + off_b(0 + 4 * hh + q4, cc) + po), tr_read(Vi + off_b(8 + 4 * hh + q4, cc) + po));
        o = MFMA32(pack8<0>(at), v0, o);
        const bf16x8 v1 = cat8(tr_read(Vi + off_b(16 + 4 * hh + q4, cc) + po), tr_read(Vi + off_b(24 + 4 * hh + q4, cc) + po));
        o = MFMA32(pack8<1>(at), v1, o);
    }
    {
        LAS unsigned char* ost = lds + GL_OST + wave * 2048;
#pragma unroll
        for (int i = 0; i < 16; ++i) { const unsigned c = (i & 3) + 8 * (i >> 2) + 4 * hh; *(LAS unsigned short*)(ost + c * 64 + 2 * r) = (unsigned short)(pk2(o[i], 0.f) & 0xffffu); }
#pragma unroll
        for (int i = 0; i < 2; ++i) { const int q = lane + 64 * i, c = q >> 2, part = q & 3, orow = dir ? 31 - c : c;
            const v4u w = *(const LAS v4u*)(ost + c * 64 + part * 16);
            *(GAS v4u*)(C.obuf + (size_t)(C.base + p0 + orow) * 2048 + C.hd * 256 + 32 * wave + part * 8) = w; }
    }
    {
        const unsigned cc = 4 * cV + 2 * blk + (p4 >> 1), po = 8 * (p4 & 1);
        const bf16x8 vb0 = cat8(tr_read(Vi + off_b(0 + 8 * hh + q4, cc) + po), tr_read(Vi + off_b(4 + 8 * hh + q4, cc) + po));
        const bf16x8 vb1 = cat8(tr_read(Vi + off_b(16 + 8 * hh + q4, cc) + po), tr_read(Vi + off_b(20 + 8 * hh + q4, cc) + po));
#pragma unroll
        for (int kt = 0; kt < 4; ++kt) {
            const LAS float* dp = (const LAS float*)(lds + GL_DEC + (n & 1) * 512) + 32 * kt + 4 * hh;
#pragma unroll
            for (int g = 0; g < 4; ++g) { const f32x4 d = *(const LAS f32x4*)(dp + 8 * g);
                St[kt][4 * g] *= d[0]; St[kt][4 * g + 1] *= d[1]; St[kt][4 * g + 2] *= d[2]; St[kt][4 * g + 3] *= d[3]; }
            const unsigned ck = 4 * kt + 2 * blk + (p4 >> 1);
            const bf16x8 ka0 = cat8(tr_read(KD + off_b(0 + 8 * hh + q4, ck) + po), tr_read(KD + off_b(4 + 8 * hh + q4, ck) + po));
            St[kt] = MFMA32(ka0, vb0, St[kt]);
            const bf16x8 ka1 = cat8(tr_read(KD + off_b(16 + 8 * hh + q4, ck) + po), tr_read(KD + off_b(20 + 8 * hh + q4, ck) + po));
            St[kt] = MFMA32(ka1, vb1, St[kt]);
        }
    }
}
#define GLA_INTERVAL(n, QV_B, KV_B, AV_B, VV_A) do { const int n__ = (n); \
        if (n__ + 1 >= 0 && n__ + 1 < nch) { gla_b2(F, C, cum, QV_B, KV_B, n__ + 1); if (n__ + 3 < nch) gla_load_qk(F, C, QV_B, KV_B, n__ + 3); } \
        if (n__ + 2 >= 0 && n__ + 2 < nch) { gla_b1(F, C, cum, n__ + 2); gla_stage_v(F, C, VV_A, vb2); if (n__ + 4 < nch) gla_load_v(F, C, VV_A, n__ + 4); } \
        if (n__ + 3 >= 0 && n__ + 3 < nch) { gla_stage_a(F, C, AV_B, n__ + 3); if (n__ + 5 < nch) gla_load_a(F, C, AV_B, n__ + 5); } \
        if (n__ >= 0) gla_mfma(F, C, St, n__, vb0); \
        __syncthreads(); \
        { const int t__ = vb0; vb0 = vb1; vb1 = vb2; vb2 = t__; } } while (0)
DI void gla_item(Frame& F, int item) {
    int seq, rem; if (item < 64) { seq = 8 + (item >> 4); rem = item & 15; } else { seq = (item - 64) >> 4; rem = (item - 64) & 15; }
    GlaCtx C; C.proj = F.PROJ; C.hd = rem >> 1; C.dir = rem & 1; C.S_len = seq_len(seq); C.base = seq_base(seq); C.nchunk = C.S_len / 32;
    const float* wa = C.dir ? F.wa_b : F.wa_f; const float* ba = C.dir ? F.ba_b : F.ba_f;
    C.acol = C.dir ? C_AB : C_AF; C.obuf = C.dir ? F.OB : F.OF;
    C.bav = *(const f32x2*)(ba + C.hd * 128 + 2 * F.lane);
    const int nch = C.nchunk;
    for (int i = F.tid; i < 16 * 128 / 4; i += NWAVES * 64) { const int j = i >> 5, c4 = i & 31; *(LAS f32x4*)((LAS float*)(F.lds + GL_WA) + j * 128 + 4 * c4) = *(const f32x4*)(wa + j * 1024 + C.hd * 128 + 4 * c4); }
    f32x16 St[4];
#pragma unroll
    for (int kt = 0; kt < 4; ++kt)
#pragma unroll
        for (int i = 0; i < 16; ++i) St[kt][i] = 0.f;
    unsigned qv0[4], kv0[4], qv1[4], kv1[4]; v4u vv0[2], vv1[2]; v4u av0 = (v4u){0u, 0u, 0u, 0u}, av1 = (v4u){0u, 0u, 0u, 0u};
    f32x2 cum[4] = {(f32x2){0.f, 0.f}, (f32x2){0.f, 0.f}, (f32x2){0.f, 0.f}, (f32x2){0.f, 0.f}};
    gla_load_a(F, C, av0, 0); gla_load_a(F, C, av1, 1); gla_load_v(F, C, vv0, 0); gla_load_v(F, C, vv1, 1); gla_load_qk(F, C, qv0, kv0, 0); gla_load_qk(F, C, qv1, kv1, 1);
    int vb0 = 2, vb1 = 0, vb2 = 1;
    __syncthreads();
    for (int n = -4; n < nch; n += 2) {
        GLA_INTERVAL(n, qv1, kv1, av1, vv0);
        GLA_INTERVAL(n + 1, qv0, kv0, av0, vv1);
    }
}

#ifndef ATT_REP
#define ATT_REP 1
#endif
DI void p3_mixers(Frame& F, int qoff) {
#ifndef NO_GLA
    for (int item = F.vcu; item < 192; item += F.G) gla_item(F, item);
#endif
    __syncthreads();
    { LAS float* bt = (LAS float*)(F.lds + ATT_BT_OFF);
      for (int idx = F.tid; idx < 16 * 384; idx += NWAVES * 64) { const int h = idx / 384, rel = idx % 384 - 192;
          bt[idx] = (rel >= -128 && rel <= 128) ? F.rel_bias[t5_bucket(rel) * 16 + h] * LOG2E : -1.0e30f; } }
    __syncthreads();
    for (;;) {
        if (F.tid == 0) F.MISC[0] = __hip_atomic_fetch_add((unsigned*)(F.ctl + CW_QUEUE + qoff), 1u, RLX_AGENT);
        __syncthreads();
        const int it = (int)F.MISC[0];
        __syncthreads();
        if (it >= 2048 + N_CONV_GRAN) break;
        if (it < 2048) attn_item(F, it);
        else { conv_granule(F, it - 2048); __syncthreads(); }
    }
}

DI void p4_combine(Frame& F) {
    const int gw = F.vcu * NWAVES + F.wave, NGW = F.G * NWAVES;
    const int hd = F.lane >> 3, part = F.lane & 7, voff = hd * 256 + part * 32;
    f32x4 gn[8];
#pragma unroll
    for (int j = 0; j < 8; ++j) gn[j] = *(const f32x4*)(F.gla_norm_g + part * 32 + 4 * j);
    for (int row = gw; row < T; row += NGW) {
        const GAS v4u* pf = (const GAS v4u*)(F.OF + (size_t)row * 2048 + voff);
        const GAS v4u* pb = (const GAS v4u*)(F.OB + (size_t)row * 2048 + voff);
        const GAS v4u* pr = (const GAS v4u*)(F.PROJ + (size_t)row * LDP + C_RG + voff);
        float o[32]; float ss = 0.f; v4u rg[4];
#pragma unroll
        for (int j = 0; j < 4; ++j) { const v4u a = pf[j], b = pb[j]; rg[j] = pr[j];
#pragma unroll
            for (int e = 0; e < 4; ++e) { const float x0 = bf_lo(a[e]) + bf_lo(b[e]), x1 = bf_hi(a[e]) + bf_hi(b[e]); o[8 * j + 2 * e] = x0; o[8 * j + 2 * e + 1] = x1; ss += x0 * x0 + x1 * x1; } }
        ss += __shfl_xor(ss, 1); ss += __shfl_xor(ss, 2); ss += __shfl_xor(ss, 4);
        const float rstd = 1.f / sqrtf(ss * (1.f / 256.f) + 1e-6f);
        GAS v4u* po = (GAS v4u*)(F.MIX + (size_t)row * D + 2048 + voff);
#pragma unroll
        for (int j = 0; j < 4; ++j) { v4u w;
#pragma unroll
            for (int e = 0; e < 4; ++e) { const float g0 = bf_lo(rg[j][e]), g1 = bf_hi(rg[j][e]);
                const float y0 = o[8 * j + 2 * e] * rstd * gn[2 * j + (e >> 1)][(2 * e) & 3] * (g0 / (1.f + __expf(-g0)));
                const float y1 = o[8 * j + 2 * e + 1] * rstd * gn[2 * j + (e >> 1)][(2 * e + 1) & 3] * (g1 / (1.f + __expf(-g1)));
                w[e] = pk2(y0, y1); }
            po[j] = w; }
    }
}

struct RepOrder : pg8::StaticOrder {
    int ncu, rep;
    __device__ void setrep(int r) { rep = r; ncu = 0; pg8::Unit u; while (pg8::StaticOrder::next(ncu, u)) ++ncu; }
    __device__ bool next(int i, pg8::Unit& u) const { if (i >= rep * ncu) return false;
#if PROBE_SAMETILE
        if (i >= ncu) { u.pm = 0; u.pn = 0; return true; }
#endif
        return pg8::StaticOrder::next(i % ncu, u); }
};
#ifndef STAGGER_TICKS
#define STAGGER_TICKS 0
#endif
DI void stagger(const Frame& F) {
    if (STAGGER_TICKS > 0) { const unsigned long long t0 = __builtin_amdgcn_s_memrealtime(); const unsigned long long d = (unsigned long long)(((unsigned)blockIdx.x >> 3) & 7u) * STAGGER_TICKS;
        while (__builtin_amdgcn_s_memrealtime() - t0 < d) __builtin_amdgcn_s_sleep(4); }
}
struct Args { const float* in[20]; float* out; unsigned char* ws; int ph_lo, ph_hi; };
__global__ void __launch_bounds__(NWAVES * 64, 2) fwd_kernel(Args args) {
    extern __shared__ __attribute__((aligned(16))) unsigned char lds[];
    Frame F;
    F.lds = (LAS unsigned char*)lds;
    F.MISC = (volatile LAS unsigned*)(F.lds + MISC_OFF);
    F.tid = threadIdx.x; F.lane = F.tid & 63; F.wave = __builtin_amdgcn_readfirstlane(F.tid >> 6);
    F.G = gridDim.x; { const int bx = blockIdx.x; F.vcu = (F.G % 8 == 0) ? (bx % 8) * (F.G / 8) + bx / 8 : bx; }
    unsigned char* ws = args.ws;
    F.ctl = (gu32*)(ws + WS_CTL);
    F.xp = args.in[0]; F.xs = args.in[1]; F.cp = args.in[2]; F.cs = args.in[3]; F.w_ada = args.in[4]; F.b_ada = args.in[5]; F.norm1_g = args.in[6]; F.w_in = args.in[7];
    F.wa_f = args.in[8]; F.ba_f = args.in[9]; F.wa_b = args.in[10]; F.ba_b = args.in[11]; F.gla_norm_g = args.in[12]; F.sink = args.in[13]; F.rel_bias = args.in[14];
    F.w_out = args.in[15]; F.norm2_g = args.in[16]; F.w_mi = args.in[17]; F.w_mo = args.in[18]; F.final_g = args.in[19];
    F.out = args.out; F.mod = (float*)(ws + WS_MOD);
    F.Win_t = (bf16*)(ws + WS_WIN); F.Wout_t = (bf16*)(ws + WS_WOUT); F.Wmi_t = (bf16*)(ws + WS_WMI); F.Wmo_t = (bf16*)(ws + WS_WMO);
    F.H = (bf16*)(ws + WS_H); F.H2 = (bf16*)(ws + WS_H2); F.PROJ = (bf16*)(ws + WS_PROJ); F.MIX = (bf16*)(ws + WS_MIX); F.OF = (bf16*)(ws + WS_OF); F.OB = (bf16*)(ws + WS_OB);
    F.HID0 = (bf16*)(ws + WS_HID0); F.HID1 = (bf16*)(ws + WS_HID1);
    for (int u = F.tid; u < (LDS_BYTES - LDSCTL_OFF) / 4; u += NWAVES * 64) ((LAS unsigned*)(F.lds + LDSCTL_OFF))[u] = 0u;
    __syncthreads();
    XcdBarrier bar; bar.bar = (unsigned*)(F.ctl + CW_BAR); bar.x = 0; bar.st = nullptr;
    if (MK_ONE_LAUNCH) bar = xcd_barrier_post((unsigned*)(F.ctl + CW_BAR), F.MISC + 8);
    const int lo = args.ph_lo, hi = args.ph_hi;
#ifndef PH_MASK
#define PH_MASK 0xffff
#endif
#define IN(k) ((((PH_MASK) >> (k)) & 1) && lo <= (k) && (k) < hi)
#define SEAM(k) do { if (IN(k) && IN((k) + 1)) xcd_barrier(bar); } while (0)
#ifndef PROBE_DUP
#define PROBE_DUP 0
#endif
#ifndef PROBE_P2_SP2
#define PROBE_P2_SP2 PG8_SP2
#endif
#ifndef PROBE_P2_ALIGN
#define PROBE_P2_ALIGN PG8_ALIGN
#endif
#ifndef PROBE_SAMETILE
#define PROBE_SAMETILE 0
#endif
#ifndef PROBE_NOEPI
#define PROBE_NOEPI 0
#endif
#define DUP(k) (((PROBE_DUP) >> (k)) & 1)

    if (IN(0)) { p0_prologue(F); if (DUP(0)) { xcd_barrier(bar); p0_prologue(F); } SEAM(0); }
    if (IN(1)) { norm_phase<0>(F); if (DUP(1)) { xcd_barrier(bar); norm_phase<0>(F); } SEAM(1); }
    if (IN(2)) {
        stagger(F);
        pg8::Gemm g{F.H, F.Win_t, T, LDP, D}; RepOrder S; S.init(T, LDP, F.G, (int)blockIdx.x); S.setrep(1 + DUP(2));
#if PROBE_NOEPI
        pg8::EpiBf16Probe E{F.PROJ, LDP, S.ncu, 0, F.MIX};
        pg8::gemm_phase<pg8::EpiBf16Probe, RepOrder, PG8_ALIGN, PG8_SP2>(F.lds + RING_OFF, g, S, E);
#else
        pg8::EpiBf16<0> E{F.PROJ, LDP};
        pg8::gemm_phase<pg8::EpiBf16<0>, RepOrder, PROBE_P2_ALIGN, PROBE_P2_SP2>(F.lds + RING_OFF, g, S, E);
#endif
        SEAM(2);
    }
    if (IN(3)) { p3_mixers(F, 0); SEAM(3); }
    if (IN(4)) { p4_combine(F); if (DUP(4)) { xcd_barrier(bar); p4_combine(F); } SEAM(4); }
    if (IN(5)) {
        stagger(F);
        pg8::Gemm g{F.MIX, F.Wout_t, T, D, D}; pg8::StaticOrder S; S.init(T, D, F.G, (int)blockIdx.x);
        pg8::EpiResid E{F.xp, F.xs, F.out, F.mod, OFF_G1, 0};
        pg8::gemm_phase<pg8::EpiResid, pg8::StaticOrder, PG8_ALIGN, PG8_SP2>(F.lds + RING_OFF, g, S, E);
        SEAM(5);
    }
    if (IN(6)) { norm_phase<1>(F); SEAM(6); }
#pragma unroll
    for (int c = 0; c < MLP_CH; ++c) {
        bf16* hid = (c & 1) ? F.HID1 : F.HID0;
        if (IN(7 + 2 * c)) {
            if (c == 0) stagger(F);
            pg8::Gemm g{F.H2 + (size_t)c * MLP_ROWS * D, F.Wmi_t, MLP_ROWS, DFF, D}; pg8::StaticOrder S; S.init(MLP_ROWS, DFF, F.G, (int)blockIdx.x);
            pg8::EpiBf16<1> E{hid, DFF};
            pg8::gemm_phase<pg8::EpiBf16<1>, pg8::StaticOrder, PG8_ALIGN, PG8_SP2>(F.lds + RING_OFF, g, S, E);
            SEAM(7 + 2 * c);
        }
        if (IN(8 + 2 * c)) {
            stagger(F);
            pg8::Gemm g{hid, F.Wmo_t, MLP_ROWS, D, DFF}; pg8::StaticOrder S; S.init(MLP_ROWS, D, F.G, (int)blockIdx.x);
            pg8::EpiResid E{F.out, F.out + (size_t)TP * D, F.out, F.mod, OFF_G2, c * MLP_ROWS};
            pg8::gemm_phase<pg8::EpiResid, pg8::StaticOrder, PG8_ALIGN, PG8_SP2>(F.lds + RING_OFF, g, S, E);
            if (c == MLP_CH - 1) SEAM(8 + 2 * c);
        }
    }
    if (IN(15)) norm_phase<2>(F);
#undef IN
#undef SEAM
}

extern "C" void kernel_launch(void* const* d_in, const int* in_sizes, int n_in, void* d_out, int out_size, void* d_ws, size_t ws_size, hipStream_t stream) {
    static int grid = 0;
    if (grid == 0) {
        if (n_in != 20 || out_size != T * D || ws_size < WS_END) { fprintf(stderr, "kernel_launch: unexpected shapes (n_in %d, out %d, ws %zu < %zu); nothing launched\n", n_in, out_size, ws_size, (size_t)WS_END); grid = -1; return; }
        int dev = 0, cus = 0, per_cu = 0;
        if (hipGetDevice(&dev) != hipSuccess || hipDeviceGetAttribute(&cus, hipDeviceAttributeMultiprocessorCount, dev) != hipSuccess) { grid = -1; return; }
        if (hipFuncSetAttribute((const void*)fwd_kernel, hipFuncAttributeMaxDynamicSharedMemorySize, LDS_BYTES) != hipSuccess) { fprintf(stderr, "kernel_launch: hipFuncSetAttribute failed\n"); grid = -1; return; }
        if (hipOccupancyMaxActiveBlocksPerMultiprocessor(&per_cu, (const void*)fwd_kernel, NWAVES * 64, LDS_BYTES) != hipSuccess || per_cu < 1)
            fprintf(stderr, "kernel_launch: note: occupancy query reports %d workgroups per CU\n", per_cu);
        (void)hipGetLastError();
        grid = cus;
    }
    if (grid < 0) return;
    if (hipMemsetAsync((char*)d_ws + WS_CTL, 0, CTL_ZERO_BYTES, stream) != hipSuccess) return;
    Args a{};
    for (int i = 0; i < 20; ++i) a.in[i] = (const float*)d_in[i];
    a.out = (float*)d_out; a.ws = (unsigned char*)d_ws;
#if MK_ONE_LAUNCH
    a.ph_lo = 0; a.ph_hi = N_PHASES;
    hipLaunchKernelGGL(fwd_kernel, dim3(grid), dim3(NWAVES * 64), LDS_BYTES, stream, a);
#else
    for (int p = 0; p < N_PHASES; ++p) { a.ph_lo = p; a.ph_hi = p + 1; hipLaunchKernelGGL(fwd_kernel, dim3(grid), dim3(NWAVES * 64), LDS_BYTES, stream, a); }
#endif
    const hipError_t le = hipPeekAtLastError();
    if (le != hipSuccess) fprintf(stderr, "kernel_launch: launch failed: %s\n", hipGetErrorName(le));
}
```
